# Optimizing an MI355X kernel written in HIP

```python
import math
import jax, jax.numpy as jnp
from jax import lax
import numpy as np

D_MODEL = 1024
BATCH = 4
SEQ = 8192
DEPTH = 4

HEAD_DIM = 64
A_HEADS = 4
B_HEADS = 4
C_HEADS = 4
A_WIDTH = A_HEADS * HEAD_DIM
HGRN_EXPAND = 64
B_KEY_WIDTH = B_HEADS * HGRN_EXPAND
B_WIDTH = B_HEADS * HEAD_DIM
C_QK_WIDTH = C_HEADS * 2 * HEAD_DIM
C_VDIM = 2 * HEAD_DIM
C_WIDTH = C_HEADS * C_VDIM
D_MIX = A_WIDTH + B_WIDTH + C_WIDTH
SPLIT_SIZES = (A_WIDTH, A_WIDTH, A_WIDTH,
               B_KEY_WIDTH, B_KEY_WIDTH, B_KEY_WIDTH,
               B_WIDTH, B_WIDTH,
               C_QK_WIDTH, C_QK_WIDTH, C_WIDTH)
IN_COLS = sum(SPLIT_SIZES)
ROPE_THETA = 500000.0
ROPE_DIM = HEAD_DIM // 4
DILATED_PAIRS = ((128, 1), (512, 4), (2048, 16))
SWA_BLOCK = 64
HGRN_CHUNK = 64
Q_BLOCK = 128
D_FF = 2816
CONV_WIDTH = 3
EPS = 1e-6
NEG_INF = -1e30

kernel_name = "hymba_style_dilated_hgrn2_diffattn_encoder"


def rms_norm(x, g):
    xf = x.astype(jnp.float32)
    y = xf * lax.rsqrt(jnp.mean(xf * xf, axis=-1, keepdims=True) + EPS)
    return (y * g.astype(jnp.float32)).astype(x.dtype)


def split_cols(h):
    outs, start = [], 0
    for size in SPLIT_SIZES:
        outs.append(h[..., start:start + size])
        start += size
    return outs


def rope_tables(seq):
    pos = jnp.arange(seq, dtype=jnp.float32)
    inv = ROPE_THETA ** (-jnp.arange(0, ROPE_DIM, 2, dtype=jnp.float32) / ROPE_DIM)
    ang = pos[:, None] * inv[None, :]
    return jnp.cos(ang), jnp.sin(ang)


def partial_rope(x, cos, sin):
    half = ROPE_DIM // 2
    x1, x2, rest = x[..., :half], x[..., half:ROPE_DIM], x[..., ROPE_DIM:]
    return jnp.concatenate([x1 * cos - x2 * sin, x2 * cos + x1 * sin, rest], axis=-1)


def heads(t, n):
    b, s, w = t.shape
    return t.reshape(b, s, n, w // n).transpose(0, 2, 1, 3)


def dilated_branch(q, k, v, window, dilation):
    b, h, s, hd = q.shape
    half = window // (2 * dilation)
    L = s // dilation
    nb = -(-L // SWA_BLOCK)
    Lp = nb * SWA_BLOCK

    def to_sub(t):
        return t.reshape(b, h, L, dilation, hd).transpose(0, 1, 3, 2, 4)

    qs = jnp.pad(to_sub(q), ((0, 0), (0, 0), (0, 0), (0, Lp - L), (0, 0)))
    pad_k = ((0, 0), (0, 0), (0, 0), (SWA_BLOCK, Lp - L + SWA_BLOCK), (0, 0))
    ks = jnp.pad(to_sub(k), pad_k)
    vs = jnp.pad(to_sub(v), pad_k)

    def windows(t):
        t = t.reshape(b, h, dilation, nb + 2, SWA_BLOCK, hd)
        return jnp.concatenate([t[:, :, :, 0:nb], t[:, :, :, 1:nb + 1], t[:, :, :, 2:nb + 2]], axis=-2)

    kw, vw = windows(ks), windows(vs)
    qb = qs.reshape(b, h, dilation, nb, SWA_BLOCK, hd)
    sc = jnp.einsum('bhrnqd,bhrnkd->bhrnqk', qb, kw) * (1.0 / math.sqrt(hd))
    blk = jnp.arange(nb)[:, None, None]
    qpos = blk * SWA_BLOCK + jnp.arange(SWA_BLOCK)[None, :, None]
    kpos = (blk - 1) * SWA_BLOCK + jnp.arange(3 * SWA_BLOCK)[None, None, :]
    mask = (jnp.abs(kpos - qpos) <= half) & (kpos >= 0) & (kpos < L)
    sc = jnp.where(mask, sc, NEG_INF)
    m = jnp.max(sc, axis=-1, keepdims=True)
    p = jnp.exp(sc - m)
    den = jnp.sum(p, axis=-1)
    o = jnp.einsum('bhrnqk,bhrnkd->bhrnqd', p, vw) / den[..., None]
    lse = m[..., 0] + jnp.log(den)
    o = o.reshape(b, h, dilation, Lp, hd)[:, :, :, :L].transpose(0, 1, 3, 2, 4).reshape(b, h, s, hd)
    lse = lse.reshape(b, h, dilation, Lp)[..., :L].transpose(0, 1, 3, 2).reshape(b, h, s)
    return o, lse


def dilated_mixer(q, k, v):
    outs, lses = [], []
    for window, dilation in DILATED_PAIRS:
        o, lse = dilated_branch(q, k, v, window, dilation)
        outs.append(o)
        lses.append(lse)
    w = jax.nn.softmax(jnp.stack(lses, axis=0), axis=0)
    return jnp.sum(w[..., None] * jnp.stack(outs, axis=0), axis=0)


def hgrn_scan(q, k, v, logf):
    b, h, s, dk = q.shape
    dv = v.shape[-1]
    nc = s // HGRN_CHUNK

    def chunks(t):
        return t.reshape(b, h, nc, HGRN_CHUNK, t.shape[-1]).transpose(2, 0, 1, 3, 4)

    tri = jnp.tril(jnp.ones((HGRN_CHUNK, HGRN_CHUNK), dtype=bool))[:, :, None]

    def step(state, inp):
        qc, kc, vc, gc = inp
        a = jnp.cumsum(gc, axis=-2)
        inter = jnp.einsum('bhtd,bhdv->bhtv', qc * jnp.exp(a), state)
        diff = a[:, :, :, None, :] - a[:, :, None, :, :]
        decay = jnp.exp(jnp.where(tri, diff, -jnp.inf))
        scores = jnp.einsum('bhtsd,bhsd->bhts', qc[:, :, :, None, :] * decay, kc)
        intra = jnp.einsum('bhts,bhsv->bhtv', scores, vc)
        a_last = a[:, :, -1:, :]
        new_state = (jnp.exp(a_last[:, :, 0, :])[..., None] * state
                     + jnp.einsum('bhsd,bhsv->bhdv', kc * jnp.exp(a_last - a), vc))
        return new_state, inter + intra

    init = jnp.zeros((b, h, dk, dv), jnp.float32)
    _, out = lax.scan(step, init, (chunks(q), chunks(k), chunks(v), chunks(logf)))
    return out.transpose(1, 2, 0, 3, 4).reshape(b, h, s, dv)


def hgrn_forget(z, lb):
    z = z.astype(jnp.float32)
    f = lb + (1.0 - lb) * jax.nn.sigmoid(z)
    return jnp.log(f), (1.0 - lb) * jax.nn.sigmoid(-z)


def diff_attention(q, k, v, lam):
    b, h, _, s, hd = q.shape
    nq = s // Q_BLOCK
    qb = q.reshape(b, h, 2, nq, Q_BLOCK, hd).transpose(3, 0, 1, 2, 4, 5)
    scale = 1.0 / math.sqrt(hd)

    def block(qblk):
        sc = jnp.einsum('bhcqd,bhckd->bhcqk', qblk, k) * scale
        a = jax.nn.softmax(sc.astype(jnp.float32), axis=-1)
        w = a[:, :, 0] - lam * a[:, :, 1]
        return jnp.einsum('bhqk,bhkv->bhqv', w, v)

    o = lax.map(block, qb)
    return o.transpose(1, 2, 0, 3, 4).reshape(b, h, s, v.shape[-1])


def mixer_layer(xn, w_in_l, w_out_l, lb_f, lb_b, hgrn_g, lam_p, diff_g, layer, cos, sin):
    b, s, _ = xn.shape
    (qa, ka, va, qb_, fzf, fzb, ib, gb, qc, kc, vc) = split_cols(xn @ w_in_l)

    qa = partial_rope(heads(qa, A_HEADS).astype(jnp.float32), cos, sin)
    ka = partial_rope(heads(ka, A_HEADS).astype(jnp.float32), cos, sin)
    oa = dilated_mixer(qa, ka, heads(va, A_HEADS).astype(jnp.float32))
    oa = oa.transpose(0, 2, 1, 3).reshape(b, s, A_WIDTH).astype(xn.dtype)

    logf_f, k_f = hgrn_forget(fzf, lb_f)
    logf_b, k_b = hgrn_forget(fzb, lb_b)
    qh = heads(qb_, B_HEADS).astype(jnp.float32)
    vh = heads(ib, B_HEADS).astype(jnp.float32)
    o_fwd = hgrn_scan(qh, heads(k_f, B_HEADS), vh, heads(logf_f, B_HEADS))
    flip = lambda t: jnp.flip(t, axis=2)
    o_bwd = flip(hgrn_scan(flip(qh), flip(heads(k_b, B_HEADS)), flip(vh), flip(heads(logf_b, B_HEADS))))
    ob = (o_fwd + o_bwd).transpose(0, 2, 1, 3)
    ob = rms_norm(ob, hgrn_g) * jax.nn.silu(gb.astype(jnp.float32)).reshape(b, s, B_HEADS, HEAD_DIM)
    ob = ob.reshape(b, s, B_WIDTH).astype(xn.dtype)

    lam_init = 0.8 - 0.6 * math.exp(-0.3 * layer)
    lp = lam_p.astype(jnp.float32)
    lam = jnp.exp(jnp.sum(lp[0] * lp[1])) - jnp.exp(jnp.sum(lp[2] * lp[3])) + lam_init
    qc = qc.reshape(b, s, C_HEADS, 2, HEAD_DIM).transpose(0, 2, 3, 1, 4).astype(jnp.float32)
    kc = kc.reshape(b, s, C_HEADS, 2, HEAD_DIM).transpose(0, 2, 3, 1, 4).astype(jnp.float32)
    qc = partial_rope(qc, cos, sin)
    kc = partial_rope(kc, cos, sin)
    oc = diff_attention(qc, kc, heads(vc, C_HEADS).astype(jnp.float32), lam)
    oc = rms_norm(oc.transpose(0, 2, 1, 3), diff_g) * (1.0 - lam_init)
    oc = oc.reshape(b, s, C_WIDTH).astype(xn.dtype)

    return jnp.concatenate([oa, ob, oc], axis=-1) @ w_out_l


def conv_ffn(xn, w_up_l, cw, cb, w_down_l):
    u = xn @ w_up_l
    up = jnp.pad(u, ((0, 0), (1, 1), (0, 0)))
    u = up[:, :-2] * cw[0] + up[:, 1:-1] * cw[1] + up[:, 2:] * cw[2] + cb
    gate, val = jnp.split(u, 2, axis=-1)
    return (jax.nn.silu(gate) * val) @ w_down_l


def setup_inputs(seed: int = 0) -> dict:
    key = jax.random.key(seed)
    ks = jax.random.split(key, 16)
    f32 = jnp.float32
    nrm = lambda k, shape, scale: jax.random.normal(k, shape, f32) * scale
    gain = lambda k, shape: 1.0 + 0.05 * jax.random.normal(k, shape, f32)
    return {
        "x": jax.random.normal(ks[0], (BATCH, SEQ, D_MODEL), f32),
        "w_in": nrm(ks[1], (DEPTH, D_MODEL, IN_COLS), D_MODEL ** -0.5),
        "w_out": nrm(ks[2], (DEPTH, D_MIX, D_MODEL), D_MIX ** -0.5),
        "lb_logits": nrm(ks[3], (2, DEPTH, B_KEY_WIDTH), 0.1),
        "hgrn_norm": gain(ks[4], (DEPTH, HEAD_DIM)),
        "diff_lambda": nrm(ks[5], (DEPTH, 4, HEAD_DIM), 0.1),
        "diff_norm": gain(ks[6], (DEPTH, C_VDIM)),
        "w_up": nrm(ks[7], (DEPTH, D_MODEL, 2 * D_FF), D_MODEL ** -0.5),
        "conv_w": nrm(ks[8], (DEPTH, CONV_WIDTH, 2 * D_FF), CONV_WIDTH ** -0.5),
        "conv_b": nrm(ks[9], (DEPTH, 2 * D_FF), 0.02),
        "w_down": nrm(ks[10], (DEPTH, D_FF, D_MODEL), D_FF ** -0.5),
        "norm_pre_mix": gain(ks[11], (DEPTH, D_MODEL)),
        "norm_post_mix": gain(ks[12], (DEPTH, D_MODEL)),
        "norm_pre_ffn": gain(ks[13], (DEPTH, D_MODEL)),
        "norm_post_ffn": gain(ks[14], (DEPTH, D_MODEL)),
    }


def reference(x, w_in, w_out, lb_logits, hgrn_norm, diff_lambda, diff_norm, w_up, conv_w, conv_b,
              w_down, norm_pre_mix, norm_post_mix, norm_pre_ffn, norm_post_ffn):
    cos, sin = rope_tables(x.shape[1])
    p = jax.nn.softmax(lb_logits.astype(jnp.float32), axis=1)
    lbs = jnp.cumsum(p, axis=1) - p[:, :1]
    for l in range(DEPTH):
        xn = rms_norm(x, norm_pre_mix[l])
        mix = mixer_layer(xn, w_in[l], w_out[l], lbs[0, l], lbs[1, l], hgrn_norm[l],
                          diff_lambda[l], diff_norm[l], l, cos, sin)
        x = x + rms_norm(mix, norm_post_mix[l])
        xn = rms_norm(x, norm_pre_ffn[l])
        ff = conv_ffn(xn, w_up[l], conv_w[l], conv_b[l], w_down[l])
        x = x + rms_norm(ff, norm_post_ffn[l])
    return x
```

```cpp
#include <hip/hip_runtime.h>
#include <hip/hip_bf16.h>
#include <cstdio>
#include <cstdint>
namespace pg8 {
#define PG8_LAS __attribute__((address_space(3)))
typedef unsigned short bf16_t;
typedef short bf16x8 __attribute__((ext_vector_type(8)));
typedef float f32x4 __attribute__((ext_vector_type(4)));
typedef unsigned u32x4 __attribute__((ext_vector_type(4)));
constexpr int BM = 256, BK = 64, HALF = 128, HTB = HALF * BK * 2  , STAGE_BYTES = 8 * HTB, NXCD = 8, WGM = 8;

__host__ __device__ __forceinline__ int lds_byte(int r, int c) { const int st = (r >> 4) * 2 + (c >> 5), rr = r & 15, cc = c & 31, ob = rr * 64 + cc * 2; return st * 1024 + (ob ^ (((ob >> 9) & 1) << 5)); }
__host__ __device__ __forceinline__ void stage_rc(int b, int& R, int& C) { const int st = b / 1024, sb = b % 1024, swz = sb ^ (((sb >> 9) & 1) << 5); R = (st >> 1) * 16 + swz / 64; C = (st & 1) * 32 + (swz % 64) / 2; }
__host__ __device__ __forceinline__ int perm32(int rho) { const int n = rho >> 4, i = rho & 15; return 8 * (i >> 2) + 4 * n + (i & 3); }

__device__ __forceinline__ void glds16(const void* gp, unsigned ldsaddr) { unsigned keep_; asm volatile("s_mov_b32 %0, m0\n\ts_mov_b32 m0, %2\n\ts_nop 0\n\tglobal_load_lds_dwordx4 %1, off\n\ts_mov_b32 m0, %0"
    : "=&s"(keep_) : "v"(gp), "s"((unsigned)__builtin_amdgcn_readfirstlane((int)ldsaddr)) : "memory"); }
struct Unit { int pm, pn; };
struct Gemm { const bf16_t* A; const bf16_t* Bt; int M, N, K; };

struct StaticOrder {
    int nM, nN, nwg, G, c;
    __host__ __device__ void init(int M, int N, int G_, int c_) { nM = M / BM; nN = N / BM; nwg = nM * nN; G = G_; c = c_; }
    __host__ __device__ bool next(int i, Unit& u) const {
        const long L = (long)i * G + c; if (L >= nwg) return false;
        int wgid = (int)L; { const int q = nwg / NXCD, r = nwg % NXCD, xcd = wgid % NXCD, off = wgid / NXCD; wgid = (xcd < r ? xcd * (q + 1) : r * (q + 1) + (xcd - r) * q) + off; }
        const int nig = WGM * nN, gid = wgid / nig, fm = gid * WGM, gsz = (nM - fm) < WGM ? (nM - fm) : WGM;
        u.pm = fm + ((wgid % nig) % gsz); u.pn = (wgid % nig) / gsz; return true;
    }
    __device__ __forceinline__ void a_ready(const Unit&) const {}
    __device__ __forceinline__ void done(const Unit&) const {}
};

__device__ __forceinline__ unsigned cvt_pk_bf16(float lo, float hi) { unsigned r; asm volatile("v_cvt_pk_bf16_f32 %0, %1, %2" : "=v"(r) : "v"(lo), "v"(hi)); return r; }
typedef float f32x2 __attribute__((ext_vector_type(2)));
constexpr int P_SEQ = 8192, P_NIN = 3584;
typedef unsigned u32x2v __attribute__((ext_vector_type(2)));
typedef float f32x2e __attribute__((ext_vector_type(2)));
constexpr float P_QSCALE = 0.125f * 1.4426950408889634f;
struct EpiProj {
    static constexpr bool PERM = true, PERMA = false, AFTER_DRAIN = false; static constexpr int PBYTES = 0;
    bf16_t* O; const float* rope; const float* rs;
    __device__ __forceinline__ void operator()(const f32x4 (&acc)[2][2][4][2], const Unit& u, int wr, int wc, int fr, int fq, const PG8_LAS unsigned char*) const {
        const int pn = u.pn;
        const bool isrope = (pn <= 1) || (pn >= 8 && pn <= 11);
        const float sc = (pn == 0 || pn == 8 || pn == 9) ? P_QSCALE : 1.f;
        const int row0 = u.pm * BM + wr * 64 + fr;
        const int col0 = pn * BM + wc * 32 + 8 * fq;
        const bool dorope = isrope && ((wc & 1) == 0);
#pragma unroll
        for (int ai = 0; ai < 2; ++ai)
#pragma unroll
            for (int m = 0; m < 4; ++m) {
                const int row = row0 + ai * HALF + m * 16;
                const float rsc = rs[row] * sc;
                bf16_t* rowp = O + (size_t)row * P_NIN + col0;
                if (dorope) {
                    f32x4 cs = (f32x4){rsc, rsc, rsc, rsc}, sn = (f32x4){0.f, 0.f, 0.f, 0.f};
                    if (fq < 2) { const float* rp = rope + (size_t)(row & (P_SEQ - 1)) * 16 + 4 * fq; cs = *(const f32x4*)rp * rsc; sn = *(const f32x4*)(rp + 8) * rsc; }
#pragma unroll
                    for (int bj = 0; bj < 2; ++bj) {
                        const f32x4 v0 = acc[ai][bj][m][0], v1 = acc[ai][bj][m][1];
                        const f32x4 lo = v0 * cs - v1 * sn, hi = v1 * cs + v0 * sn;
                        const unsigned l0 = cvt_pk_bf16(lo[0], lo[1]), l1 = cvt_pk_bf16(lo[2], lo[3]), h0 = cvt_pk_bf16(hi[0], hi[1]), h1 = cvt_pk_bf16(hi[2], hi[3]);
                        const unsigned s0 = (fq == 0) ? h0 : l0, s1 = (fq == 0) ? h1 : l1;
                        const unsigned r0 = __shfl_xor(s0, 16), r1 = __shfl_xor(s1, 16);
                        u32x4 w;
                        if (fq == 0) { w.x = l0; w.y = l1; w.z = r0; w.w = r1; } else if (fq == 1) { w.x = r0; w.y = r1; w.z = h0; w.w = h1; } else { w.x = l0; w.y = l1; w.z = h0; w.w = h1; }
                        *(u32x4*)(rowp + bj * HALF) = w;
                    }
                } else {
#pragma unroll
                    for (int bj = 0; bj < 2; ++bj) {
                        const f32x4 v0 = acc[ai][bj][m][0] * rsc, v1 = acc[ai][bj][m][1] * rsc;
                        u32x4 w; w.x = cvt_pk_bf16(v0[0], v0[1]); w.y = cvt_pk_bf16(v0[2], v0[3]); w.z = cvt_pk_bf16(v1[0], v1[1]); w.w = cvt_pk_bf16(v1[2], v1[3]);
                        *(u32x4*)(rowp + bj * HALF) = w;
                    }
                }
            }
    }
};
struct EpiBf16P {
    static constexpr bool PERM = true, PERMA = false, AFTER_DRAIN = false; static constexpr int PBYTES = 0;
    bf16_t* O; int ldc;
    __device__ __forceinline__ void operator()(const f32x4 (&acc)[2][2][4][2], const Unit& u, int wr, int wc, int fr, int fq, const PG8_LAS unsigned char*) const {
        const int row0 = u.pm * BM + wr * 64 + fr, col0 = u.pn * BM + wc * 32 + 8 * fq;
#pragma unroll
        for (int ai = 0; ai < 2; ++ai)
#pragma unroll
            for (int m = 0; m < 4; ++m) { bf16_t* rowp = O + (size_t)(row0 + ai * HALF + m * 16) * ldc + col0;
#pragma unroll
                for (int bj = 0; bj < 2; ++bj) { const f32x4 v0 = acc[ai][bj][m][0], v1 = acc[ai][bj][m][1];
                    u32x4 w; w.x = cvt_pk_bf16(v0[0], v0[1]); w.y = cvt_pk_bf16(v0[2], v0[3]); w.z = cvt_pk_bf16(v1[0], v1[1]); w.w = cvt_pk_bf16(v1[2], v1[3]);
                    *(u32x4*)(rowp + bj * HALF) = w; } }
    }
};
struct EpiF32 {
    static constexpr bool PERM = false, PERMA = false, AFTER_DRAIN = false; static constexpr int PBYTES = 0;
    float* O; int ldc;
    __device__ __forceinline__ void operator()(const f32x4 (&acc)[2][2][4][2], const Unit& u, int wr, int wc, int fr, int fq, const PG8_LAS unsigned char*) const {
        const int row0 = u.pm * BM + wr * 64 + fr, col0 = u.pn * BM + wc * 32 + 4 * fq;
#pragma unroll
        for (int ai = 0; ai < 2; ++ai)
#pragma unroll
            for (int m = 0; m < 4; ++m) { float* rowp = O + (size_t)(row0 + ai * HALF + m * 16) * ldc + col0;
#pragma unroll
                for (int bj = 0; bj < 2; ++bj)
#pragma unroll
                    for (int n = 0; n < 2; ++n) *(f32x4*)(rowp + bj * HALF + n * 16) = acc[ai][bj][m][n]; }
    }
};
constexpr int P_DFF = 2816, P_NUP = 5632;
__device__ __forceinline__ float dpp_shr1(float old, float src) { return __builtin_bit_cast(float, __builtin_amdgcn_update_dpp(__builtin_bit_cast(int, old), __builtin_bit_cast(int, src), 0x111, 0xF, 0xF, false)); }
__device__ __forceinline__ float dpp_shl1(float old, float src) { return __builtin_bit_cast(float, __builtin_amdgcn_update_dpp(__builtin_bit_cast(int, old), __builtin_bit_cast(int, src), 0x101, 0xF, 0xF, false)); }
__device__ __forceinline__ float dpp_ror1(float src) { return __builtin_bit_cast(float, __builtin_amdgcn_mov_dpp(__builtin_bit_cast(int, src), 0x121, 0xF, 0xF, true)); }
__device__ __forceinline__ float dpp_shr1z(float src) { return __builtin_bit_cast(float, __builtin_amdgcn_mov_dpp(__builtin_bit_cast(int, src), 0x111, 0xF, 0xF, true)); }
__device__ __forceinline__ float dpp_shl1z(float src) { return __builtin_bit_cast(float, __builtin_amdgcn_mov_dpp(__builtin_bit_cast(int, src), 0x101, 0xF, 0xF, true)); }
__device__ __forceinline__ float dpp_rol1(float src) { return __builtin_bit_cast(float, __builtin_amdgcn_mov_dpp(__builtin_bit_cast(int, src), 0x12F, 0xF, 0xF, true)); }
struct EpiConv {
    static constexpr bool PERM = true, PERMA = true, AFTER_DRAIN = false; static constexpr int PBYTES = 5120;
    bf16_t* act; bf16_t* halo; const float* cw; const float* cb; const float* rs;
    __device__ __forceinline__ void stage(const Unit& u, unsigned pb, int wid, int lane) const {
        if (wid < 5) {
            const int a = 2 * wid + (lane >> 5), tap = a & 3;
            const float* src = (wid == 4) ? rs + u.pm * BM + 4 * lane : (tap == 3 ? cb : cw + tap * P_NUP) + (a >> 2) * P_DFF + u.pn * 128 + 4 * (lane & 31);
            glds16(src, pb + wid * 1024);
        }
    }
    __device__ __forceinline__ void operator()(const f32x4 (&acc)[2][2][4][2], const Unit& u, int wr, int wc, int fr_, int fq_, const PG8_LAS unsigned char* pb) const {
        int fr = fr_, fq = fq_; asm volatile("" : "+v"(fr), "+v"(fq));
        const int cbase = u.pn * 128 + wc * 32 + 8 * fq;
        const PG8_LAS unsigned char* pw = pb + (wc * 32 + 8 * fq) * 4;
        constexpr float L2E = 1.4426950408889634f, LN2 = 0.6931471805599453f;
        const bool lo = (fr == 0), hi = (fr == 15);
#pragma unroll
        for (int ai = 0; ai < 2; ++ai) {
            const int blk = u.pm * 4 + ai * 2 + wr;
            const int rowb = blk * 64 + 4 * fr;
            const f32x4 rsm = *(const PG8_LAS f32x4*)(pb + 4096 + ((ai * 2 + wr) * 64 + 4 * fr) * 4);
            u32x2v pk[2][4], hg[2][2], hv[2][2];
#pragma unroll
            for (int n = 0; n < 2; ++n) {
#pragma unroll
                for (int h = 0; h < 2; ++h) {
#define EPC_W(a) (*(const PG8_LAS f32x2e*)(pw + (a) * 512 + n * 16 + h * 8))
                    const f32x2e g0 = EPC_W(0) * L2E, g1 = EPC_W(1) * L2E, g2 = EPC_W(2) * L2E, gb = EPC_W(3) * L2E, v0 = EPC_W(4) * LN2, v1 = EPC_W(5) * LN2, v2 = EPC_W(6) * LN2, vb = EPC_W(7) * LN2;
#undef EPC_W
                    f32x2e Gs[4], Vs[4];
#pragma unroll
                    for (int m = 0; m < 4; ++m) { Gs[m] = (f32x2e){acc[ai][0][m][n][2 * h], acc[ai][0][m][n][2 * h + 1]} * rsm[m]; Vs[m] = (f32x2e){acc[ai][1][m][n][2 * h], acc[ai][1][m][n][2 * h + 1]} * rsm[m]; }
                    f32x2e Gm1, Gp4, Vm1, Vp4;
#pragma unroll
                    for (int j = 0; j < 2; ++j) { Gm1[j] = dpp_shr1z(Gs[3][j]); Vm1[j] = dpp_shr1z(Vs[3][j]); Gp4[j] = dpp_shl1z(Gs[0][j]); Vp4[j] = dpp_shl1z(Vs[0][j]); }
#pragma unroll
                    for (int m = 0; m < 4; ++m) {
                        const f32x2e Gp = m == 0 ? Gm1 : Gs[m > 0 ? m - 1 : 0], Gn = m == 3 ? Gp4 : Gs[m < 3 ? m + 1 : 3], Vp = m == 0 ? Vm1 : Vs[m > 0 ? m - 1 : 0], Vn = m == 3 ? Vp4 : Vs[m < 3 ? m + 1 : 3];
                        const f32x2e g = __builtin_elementwise_fma(Gp, g0, __builtin_elementwise_fma(Gs[m], g1, __builtin_elementwise_fma(Gn, g2, gb)));
                        const f32x2e v = __builtin_elementwise_fma(Vp, v0, __builtin_elementwise_fma(Vs[m], v1, __builtin_elementwise_fma(Vn, v2, vb)));
                        f32x2e sg;
#pragma unroll
                        for (int j = 0; j < 2; ++j) sg[j] = __builtin_amdgcn_rcpf(1.f + __builtin_amdgcn_exp2f(-g[j]));
                        const f32x2e o = g * sg * v;
                        const unsigned w = cvt_pk_bf16(o[0], o[1]);
                        if (h == 0) pk[n][m].x = w; else pk[n][m].y = w;
                    }
#pragma unroll
                    for (int q = 0; q < 2; ++q) {
                        f32x2e hgv, hvv;
#pragma unroll
                        for (int j = 0; j < 2; ++j) { hgv[j] = hi ? Gs[q + 2][j] : Gs[q][j]; hvv[j] = hi ? Vs[q + 2][j] : Vs[q][j]; }
                        const unsigned wg_ = cvt_pk_bf16(hgv[0], hgv[1]), wv_ = cvt_pk_bf16(hvv[0], hvv[1]);
                        if (h == 0) { hg[n][q].x = wg_; hv[n][q].x = wv_; } else { hg[n][q].y = wg_; hv[n][q].y = wv_; }
                    }
                }
            }
#pragma unroll
            for (int m = 0; m < 4; ++m) {
                const bool edge = (m == 0 && lo) || (m == 3 && hi);
                if (!edge) { u32x4 w; w.x = pk[0][m].x; w.y = pk[0][m].y; w.z = pk[1][m].x; w.w = pk[1][m].y; *(u32x4*)(act + (size_t)(rowb + m) * P_DFF + cbase) = w; }
            }
            if (lo || hi) {
#pragma unroll
                for (int q = 0; q < 2; ++q) { bf16_t* hp = halo + ((size_t)blk * 4 + q + (hi ? 2 : 0)) * P_NUP + cbase;
                    u32x4 wg, wv; wg.x = hg[0][q].x; wg.y = hg[0][q].y; wg.z = hg[1][q].x; wg.w = hg[1][q].y; wv.x = hv[0][q].x; wv.y = hv[0][q].y; wv.z = hv[1][q].x; wv.w = hv[1][q].y;
                    *(u32x4*)hp = wg; *(u32x4*)(hp + P_DFF) = wv; }
            }
        }
    }
};
template <class Epi, class Sched, bool ALIGN_EPI = false, bool SP2 = false>
__device__ __forceinline__ void gemm_phase(PG8_LAS unsigned char* lds, const Gemm g, const Sched& S, const Epi& E) {
    int tid_ = threadIdx.x; asm volatile("" : "+v"(tid_));
    const int tid = tid_, wid = __builtin_amdgcn_readfirstlane(tid >> 6), lane = tid & 63, wr = wid >> 2, wc = wid & 3, fr = lane & 15, fq = lane >> 4;
    const int K = g.K, nt = K / BK;
    unsigned voffA[2], voffB[2];
#pragma unroll
    for (int i = 0; i < 2; ++i) { int R, C; stage_rc(tid * 16 + i * 8192, R, C); const int Rb = Epi::PERM ? ((R & ~31) + perm32(R & 31)) : R;
        const int Ra = Epi::PERMA ? ((R & 64) + 4 * (R & 15) + ((R >> 4) & 3)) : R;
        voffA[i] = (unsigned)(Ra * K + C) * 2u; voffB[i] = (unsigned)(Rb * K + C) * 2u; }
    const size_t kstep = (size_t)(BK * 2);
    const size_t hstep = (size_t)HALF * K * 2;
    const size_t tstep = 2 * hstep;
    const unsigned ldsw = (unsigned)wid * 1024u;
    const int aoff = lds_byte(wr * 64 + fr, fq * 8), boff = lds_byte(wc * 32 + fr, fq * 8);
#define PG8_SA(b, h) (((b) * 2 + (h)) * HTB)
#define PG8_SB(b, h) ((4 + (b) * 2 + (h)) * HTB)
#define PG8_STAGE(bufoff, gbase, voff) do { _Pragma("unroll") for (int _i = 0; _i < 2; ++_i) \
        __builtin_amdgcn_global_load_lds((const unsigned*)((const char*)(gbase) + (voff)[_i]), (PG8_LAS unsigned*)(lds + (bufoff) + ldsw + _i * 8192), 16, 0, 0); } while (0)
#define PG8_LDA(dst, b, h) do { _Pragma("unroll") for (int m = 0; m < 4; ++m) _Pragma("unroll") for (int k = 0; k < 2; ++k) dst[m][k] = *(const PG8_LAS bf16x8*)(lds + PG8_SA(b, h) + aoff + m * 2048 + k * 1024); } while (0)
#define PG8_LDB(dst, b, h) do { _Pragma("unroll") for (int n = 0; n < 2; ++n) _Pragma("unroll") for (int k = 0; k < 2; ++k) dst[n][k] = *(const PG8_LAS bf16x8*)(lds + PG8_SB(b, h) + boff + n * 2048 + k * 1024); } while (0)
#define PG8_MMA(ai, bj, At, Bt) do { __builtin_amdgcn_s_setprio(1); _Pragma("unroll") for (int m = 0; m < 4; ++m) _Pragma("unroll") for (int n = 0; n < 2; ++n) _Pragma("unroll") for (int k = 0; k < 2; ++k) \
        acc[ai][bj][m][n] = __builtin_amdgcn_mfma_f32_16x16x32_bf16(Bt[n][k], At[m][k], acc[ai][bj][m][n], 0, 0, 0); __builtin_amdgcn_s_setprio(0); } while (0)
#define PG8_WAIT_V(n) asm volatile("s_waitcnt vmcnt(" #n ")" ::: "memory")
#define PG8_WAIT_L(n) asm volatile("s_waitcnt lgkmcnt(" #n ")" ::: "memory")
#define PG8_BAR __builtin_amdgcn_s_barrier()
#define PG8_SCHED __builtin_amdgcn_sched_barrier(0)
    Unit cur, nxt; int ui = 0;
    if (!S.next(0, cur)) return;
    f32x4 acc[2][2][4][2];
#pragma unroll
    for (int a = 0; a < 2; ++a)
#pragma unroll
        for (int b = 0; b < 2; ++b)
#pragma unroll
            for (int m = 0; m < 4; ++m)
#pragma unroll
                for (int n = 0; n < 2; ++n) acc[a][b][m][n] = (f32x4){0.f, 0.f, 0.f, 0.f};
    bf16x8 At[4][2], B0[2][2], B1[2][2];
    const char* cA = (const char*)g.A + (size_t)cur.pm * tstep; const char* cB = (const char*)g.Bt + (size_t)cur.pn * tstep;
    S.a_ready(cur);
    if constexpr (SP2) {
        PG8_STAGE(PG8_SB(0, 0), cB, voffB); PG8_STAGE(PG8_SB(0, 1), cB + hstep, voffB); PG8_STAGE(PG8_SA(0, 0), cA, voffA); PG8_STAGE(PG8_SA(0, 1), cA + hstep, voffA);
        if (wr == 1) PG8_BAR;
        PG8_WAIT_V(2); PG8_BAR;
        PG8_STAGE(PG8_SB(1, 0), cB + kstep, voffB); PG8_STAGE(PG8_SA(1, 0), cA + kstep, voffA); PG8_STAGE(PG8_SB(1, 1), cB + hstep + kstep, voffB);
        PG8_WAIT_V(6); PG8_BAR;
    } else {
        PG8_STAGE(PG8_SB(0, 0), cB, voffB); PG8_STAGE(PG8_SA(0, 0), cA, voffA); PG8_STAGE(PG8_SB(0, 1), cB + hstep, voffB); PG8_STAGE(PG8_SA(0, 1), cA + hstep, voffA);
        if (wr == 1) PG8_BAR;
        PG8_WAIT_V(4); PG8_BAR;
        PG8_STAGE(PG8_SB(1, 0), cB + kstep, voffB); PG8_STAGE(PG8_SA(1, 0), cA + kstep, voffA); PG8_STAGE(PG8_SB(1, 1), cB + hstep + kstep, voffB);
        PG8_WAIT_V(6); PG8_BAR;
    }
    for (;;) {
        const bool has_next = S.next(ui + 1, nxt);
        const char* nA = has_next ? (const char*)g.A + (size_t)nxt.pm * tstep : cA; const char* nB = has_next ? (const char*)g.Bt + (size_t)nxt.pn * tstep : cB;
        const unsigned pboff = (unsigned)STAGE_BYTES + (unsigned)(ui & 1) * (unsigned)Epi::PBYTES;
        if constexpr (Epi::PBYTES > 0) E.stage(cur, (unsigned)(uintptr_t)lds + pboff, wid, lane);
        for (int t = 0; t < nt; t += 2) {
            const bool last = (t == nt - 2);
            const char* a1 = cA + (size_t)(t + 1) * kstep;
            const char* a2 = last ? nA : cA + (size_t)(t + 2) * kstep; const char* b2 = last ? nB : cB + (size_t)(t + 2) * kstep;
            const char* a3 = a2 + kstep; const char* b3 = b2 + kstep;
            if (last && has_next) S.a_ready(nxt);
            if constexpr (SP2) {
            PG8_LDB(B0, 0, 0); PG8_LDB(B1, 0, 1); PG8_SCHED; PG8_LDA(At, 0, 0); PG8_STAGE(PG8_SA(1, 1), a1 + hstep, voffA);
            PG8_WAIT_V(8); PG8_WAIT_L(0); PG8_BAR; PG8_MMA(0, 0, At, B0); PG8_MMA(0, 1, At, B1); PG8_BAR; PG8_SCHED;
            PG8_LDA(At, 0, 1); PG8_STAGE(PG8_SB(0, 0), b2, voffB); PG8_STAGE(PG8_SB(0, 1), b2 + hstep, voffB); PG8_STAGE(PG8_SA(0, 0), a2, voffA);
            PG8_WAIT_V(8); PG8_WAIT_L(0); PG8_BAR; PG8_MMA(1, 0, At, B0); PG8_MMA(1, 1, At, B1); PG8_BAR; PG8_SCHED;
            PG8_LDB(B0, 1, 0); PG8_LDB(B1, 1, 1); PG8_SCHED; PG8_LDA(At, 1, 0); PG8_STAGE(PG8_SA(0, 1), a2 + hstep, voffA);
            PG8_WAIT_V(8); PG8_WAIT_L(0); PG8_BAR; PG8_MMA(0, 0, At, B0); PG8_MMA(0, 1, At, B1); PG8_BAR; PG8_SCHED;
            PG8_LDA(At, 1, 1); PG8_STAGE(PG8_SB(1, 0), b3, voffB); PG8_STAGE(PG8_SB(1, 1), b3 + hstep, voffB); PG8_STAGE(PG8_SA(1, 0), a3, voffA);
            PG8_WAIT_V(8); PG8_WAIT_L(0); PG8_BAR; PG8_MMA(1, 0, At, B0); PG8_MMA(1, 1, At, B1); PG8_BAR; PG8_SCHED;
            } else {
            PG8_LDB(B0, 0, 0); PG8_SCHED; PG8_LDA(At, 0, 0); PG8_STAGE(PG8_SA(1, 1), a1 + hstep, voffA);
            PG8_WAIT_L(8); PG8_BAR; PG8_WAIT_L(0); PG8_MMA(0, 0, At, B0); PG8_BAR; PG8_SCHED;
            PG8_LDB(B1, 0, 1); PG8_STAGE(PG8_SB(0, 0), b2, voffB);
            PG8_BAR; PG8_WAIT_L(0); PG8_MMA(0, 1, At, B1); PG8_BAR;
            PG8_LDA(At, 0, 1); PG8_STAGE(PG8_SA(0, 0), a2, voffA);
            PG8_BAR; PG8_WAIT_L(0); PG8_MMA(1, 0, At, B0); PG8_BAR; PG8_SCHED;
            PG8_STAGE(PG8_SB(0, 1), b2 + hstep, voffB);
            PG8_WAIT_V(6); PG8_BAR; PG8_MMA(1, 1, At, B1); PG8_BAR;
            PG8_LDB(B0, 1, 0); PG8_SCHED; PG8_LDA(At, 1, 0); PG8_STAGE(PG8_SA(0, 1), a2 + hstep, voffA);
            PG8_WAIT_L(8); PG8_BAR; PG8_WAIT_L(0); PG8_MMA(0, 0, At, B0); PG8_BAR; PG8_SCHED;
            PG8_LDB(B1, 1, 1); PG8_STAGE(PG8_SB(1, 0), b3, voffB);
            PG8_BAR; PG8_WAIT_L(0); PG8_MMA(0, 1, At, B1); PG8_BAR;
            PG8_LDA(At, 1, 1); PG8_STAGE(PG8_SA(1, 0), a3, voffA);
            PG8_BAR; PG8_WAIT_L(0); PG8_MMA(1, 0, At, B0); PG8_BAR; PG8_SCHED;
            PG8_STAGE(PG8_SB(1, 1), b3 + hstep, voffB);
            PG8_WAIT_V(6); PG8_BAR; PG8_MMA(1, 1, At, B1); PG8_BAR;
            }
        }
        if constexpr (ALIGN_EPI) { if (wr == 0) PG8_BAR; }
        if constexpr (!Epi::AFTER_DRAIN) { E(acc, cur, wr, wc, fr, fq, lds + pboff); S.done(cur); }
        if (!has_next) break;
#pragma unroll
        for (int a = 0; a < 2; ++a)
#pragma unroll
            for (int b = 0; b < 2; ++b)
#pragma unroll
                for (int m = 0; m < 4; ++m)
#pragma unroll
                    for (int n = 0; n < 2; ++n) acc[a][b][m][n] = (f32x4){0.f, 0.f, 0.f, 0.f};
        cur = nxt; cA = nA; cB = nB; ++ui;
        if constexpr (ALIGN_EPI) { if (wr == 1) PG8_BAR; }
    }
    PG8_WAIT_V(0);
    if constexpr (!ALIGN_EPI) { if (wr == 0) PG8_BAR; }
    PG8_BAR;
    if constexpr (Epi::AFTER_DRAIN) { E.fused(acc, cur, wr, wc, fr, fq, lds, wid, lane); S.done(cur); }
#undef PG8_SA
#undef PG8_SB
#undef PG8_STAGE
#undef PG8_LDA
#undef PG8_LDB
#undef PG8_MMA
#undef PG8_WAIT_V
#undef PG8_WAIT_L
#undef PG8_BAR
#undef PG8_SCHED
}
}

constexpr int BATCH = 4, SEQ = 8192, DM = 1024, DEPTH = 4, MTOK = BATCH * SEQ;
constexpr int NIN = 3584, DFF = 2816, NUP = 2 * DFF;
constexpr int COL_QA = 0, COL_KA = 256, COL_VA = 512, COL_QB = 768, COL_FZF = 1024, COL_FZB = 1280, COL_IB = 1536, COL_GB = 1792, COL_QC = 2048, COL_KC = 2560, COL_VC = 3072;
constexpr float EPS = 1e-6f;
constexpr int NWAVES = 8;
constexpr int MHALF = MTOK / 2;

constexpr size_t MiB = 1u << 20;
constexpr size_t WS_CTL = 0, CTL_ZERO_BYTES = 64 * 1024;
constexpr size_t WS_ROPE = 1 * MiB;
constexpr size_t WS_LBS = 1 * MiB + 640 * 1024;
constexpr size_t WS_LAM = WS_LBS + 16 * 1024;
constexpr size_t WS_RS = 1 * MiB + 768 * 1024;
constexpr size_t WS_WIN = 2 * MiB;
constexpr size_t WS_WOUT = 9 * MiB;
constexpr size_t WS_WUP = 11 * MiB;
constexpr size_t WS_WDN = 22 * MiB;
constexpr size_t WS_HD = 27 * MiB + 512 * 1024;
constexpr size_t WS_XN = 28 * MiB;
constexpr size_t WS_BIG = 92 * MiB;
constexpr size_t WS_ACT = WS_BIG;
constexpr size_t WS_HALO = WS_BIG + 176 * MiB;
constexpr size_t WS_BR = 356 * MiB;
constexpr size_t WS_X16 = WS_BR + 64 * MiB;
constexpr size_t WS_HS = WS_BR;
constexpr size_t WS_HO = WS_BR + 32 * MiB;
constexpr size_t WS_END = 484 * MiB;
constexpr int CW_BAR = 1024;

constexpr int RING_BYTES = 131072;
constexpr int LDSCTL_OFF = 146432, MISC_OFF = LDSCTL_OFF + 320;
constexpr int LDS_BYTES = 147456;

#define GAS __attribute__((address_space(1)))
#define LAS __attribute__((address_space(3)))
typedef unsigned short bf16_t;
typedef short bf16x8 __attribute__((ext_vector_type(8)));
typedef short s16x4 __attribute__((ext_vector_type(4)));
typedef float f32x4 __attribute__((ext_vector_type(4)));
typedef float f32x2 __attribute__((ext_vector_type(2)));
typedef float f32x16 __attribute__((ext_vector_type(16)));
typedef unsigned u32x4 __attribute__((ext_vector_type(4)));
typedef unsigned u32x2 __attribute__((ext_vector_type(2)));
typedef GAS unsigned gu32;
#define RLX_AGENT __ATOMIC_RELAXED, __HIP_MEMORY_SCOPE_AGENT
#define LDS_WAIT() asm volatile("s_waitcnt lgkmcnt(0)" ::: "memory")
#define VM_WAIT() asm volatile("s_waitcnt vmcnt(0)" ::: "memory")
#define MFMA32(a, b, c) __builtin_amdgcn_mfma_f32_32x32x16_bf16((a), (b), (c), 0, 0, 0)
__device__ __forceinline__ unsigned f2bf(float f) { unsigned u = __builtin_bit_cast(unsigned, f); return (u + 0x7fffu + ((u >> 16) & 1u)) >> 16; }
__device__ __forceinline__ unsigned pk2(float lo, float hi) { return f2bf(lo) | (f2bf(hi) << 16); }
__device__ __forceinline__ float bf2f(unsigned short b) { return __builtin_bit_cast(float, (unsigned)b << 16); }
typedef __bf16 bf16x2_t __attribute__((ext_vector_type(2)));
__device__ __forceinline__ unsigned cvtpk(float lo, float hi) { f32x2 v = {lo, hi}; bf16x2_t b = __builtin_convertvector(v, bf16x2_t); return __builtin_bit_cast(unsigned, b); }
__device__ __forceinline__ unsigned short f2bf1(float x) { return (unsigned short)(cvtpk(x, 0.f) & 0xffffu); }
__device__ __forceinline__ int crow(int r, int hi) { return (r & 3) + 8 * (r >> 2) + 4 * hi; }
typedef short v4i16_t __attribute__((ext_vector_type(4)));
__device__ __forceinline__ s16x4 vtr(const LAS unsigned char* p) { return __builtin_bit_cast(s16x4, __builtin_amdgcn_ds_read_tr16_b64_v4i16((LAS v4i16_t*)p)); }
__device__ __forceinline__ bf16x8 cat8(s16x4 lo, s16x4 hi) { return (bf16x8){lo[0], lo[1], lo[2], lo[3], hi[0], hi[1], hi[2], hi[3]}; }
__device__ __forceinline__ float wave_sum(float v) {
#pragma unroll
    for (int o = 1; o < 64; o <<= 1) v += __shfl_xor(v, o);
    return v;
}
#define MX3(a, b, c) __builtin_fmaxf(__builtin_fmaxf((a), (b)), (c))
__device__ __forceinline__ float xhalf_max(float m) { auto rr = __builtin_amdgcn_permlane32_swap(__float_as_uint(m), __float_as_uint(m), false, false); return __builtin_fmaxf(__uint_as_float(rr[0]), __uint_as_float(rr[1])); }
__device__ __forceinline__ float xhalf_sum(float m) { auto rr = __builtin_amdgcn_permlane32_swap(__float_as_uint(m), __float_as_uint(m), false, false); return __uint_as_float(rr[0]) + __uint_as_float(rr[1]); }
__device__ __forceinline__ int opaque_tid() { int t = threadIdx.x; asm volatile("" : "+v"(t)); return t; }
#define XB_TMO      128
#define XB_XCNT(j)  (256  + 64 * (j))
#define XB_XSUB(j)  (1280 + 64 * (j))
#define XB_XGEN(j)  (2304 + 64 * (j))
#define XB_TOP      3328
#define XB_TOPGEN   3392
#define XCD_BAR_WORDS 3456
#define XB_SPIN_CAP (1u << 18)

__device__ __forceinline__ unsigned xb_ld(unsigned* p)              { return __hip_atomic_load(p, __ATOMIC_RELAXED, __HIP_MEMORY_SCOPE_AGENT); }
__device__ __forceinline__ unsigned xb_add(unsigned* p, unsigned v) { return __hip_atomic_fetch_add(p, v, __ATOMIC_RELAXED, __HIP_MEMORY_SCOPE_AGENT); }
__device__ __forceinline__ unsigned xb_xcc_id() { return (unsigned)__builtin_amdgcn_s_getreg((3 << 11) | 20) & 0xFu; }
#define XB_SPIN(cond, bar) do { unsigned _sp = 0; while (cond) { __builtin_amdgcn_s_sleep(1); \
    if ((++_sp & 255u) == 0u) { if (xb_ld(&(bar)[XB_TMO])) break; if (_sp > XB_SPIN_CAP) { atomicAdd(&(bar)[XB_TMO], 1u); break; } } } } while (0)

struct XcdBarrier {
    unsigned* bar; unsigned x;
    volatile LAS unsigned* st;
};

__device__ __forceinline__ XcdBarrier xcd_barrier_post(unsigned* bar, volatile LAS unsigned* st) {
    XcdBarrier b; b.bar = bar; b.x = xb_xcc_id(); b.st = st;
    if (threadIdx.x == 0) (void)xb_add(&bar[XB_XCNT(b.x)], 1u);
    return b;
}
__device__ __forceinline__ void xcd_barrier_complete(unsigned* bar, unsigned x, unsigned& nloc, unsigned& nx) {
    const unsigned G = gridDim.x * gridDim.y * gridDim.z;
    unsigned sum, cnt, mine, sp = 0u;
    for (;;) {
        sum = 0u; cnt = 0u; mine = 0u;
#pragma unroll
        for (unsigned j = 0; j < 16; ++j) { const unsigned c = xb_ld(&bar[XB_XCNT(j)]); sum += c; cnt += (c > 0u) ? 1u : 0u; mine = (j == x) ? c : mine; }
        if (sum == G) break;
        __builtin_amdgcn_s_sleep(1);
        if ((++sp & 255u) == 0u) { if (xb_ld(&bar[XB_TMO])) break; if (sp > XB_SPIN_CAP) { atomicAdd(&bar[XB_TMO], 1u); break; } }
    }
    nloc = mine > 0u ? mine : 1u; nx = cnt > 0u ? cnt : 1u;
}

__device__ __forceinline__ void xcd_barrier(const XcdBarrier& b) {
    asm volatile("s_waitcnt vmcnt(0)" ::: "memory");
    __syncthreads();
    if (threadIdx.x == 0) {
        unsigned* bar = b.bar; const unsigned bx = xb_xcc_id();
        __builtin_amdgcn_s_waitcnt(0);
        unsigned nloc = b.st[0], nx = b.st[1];
        if (nloc == 0u) { xcd_barrier_complete(bar, bx, nloc, nx); b.st[0] = nloc; b.st[1] = nx; }
        const unsigned old = xb_add(&bar[XB_XSUB(bx)], 1u);
        const unsigned gen = old / nloc;
        if (old + 1u == (gen + 1u) * nloc) {
            __builtin_amdgcn_fence(__ATOMIC_RELEASE, "agent");
            asm volatile("s_waitcnt vmcnt(0)" ::: "memory");
            const unsigned og = xb_add(&bar[XB_TOP], 1u);
            const unsigned tg = og / nx;
            if (og + 1u == (tg + 1u) * nx) xb_add(&bar[XB_TOPGEN], 1u);
            else XB_SPIN(xb_ld(&bar[XB_TOPGEN]) == tg, bar);
            __builtin_amdgcn_fence(__ATOMIC_ACQUIRE, "agent");
            xb_add(&bar[XB_XGEN(bx)], 1u);
            asm volatile("s_waitcnt vmcnt(0)" ::: "memory");
        } else {
            XB_SPIN(xb_ld(&bar[XB_XGEN(bx)]) == gen, bar);
            __builtin_amdgcn_fence(__ATOMIC_ACQUIRE, "agent");
            asm volatile("s_waitcnt vmcnt(0)" ::: "memory");
        }
    }
    __syncthreads();
}

struct Frame {
    LAS unsigned char* lds;
    int wave;
    int vcu, G;
    unsigned char* ws;
};

__device__ __forceinline__ void prologue_small(Frame& F, const float* lb_logits, const float* diff_lambda) {
    const int L_tid = opaque_tid(), L_lane = L_tid & 63;
    const int gt = F.vcu * (NWAVES * 64) + L_tid, NT = F.G * NWAVES * 64;
    float* rope = (float*)(F.ws + WS_ROPE);
    for (int i = gt; i < SEQ * 8; i += NT) {
        const int pos = i >> 3, j = i & 7;
        const double inv = (j == 0) ? 1.0 : (j == 1) ? 0.19392274474868576 : (j == 2) ? 0.03760603093086393 : (j == 3) ? 0.007292664737217109 : (j == 4) ? 0.001414213562373095
                         : (j == 5) ? 0.0002742481756762073 : (j == 6) ? 5.318295896944988e-05 : 1.031338537721246e-05;
        const double rev = (double)pos * inv * 0.15915494309189535;
        const double fr = rev - __builtin_rint(rev);
        const float f = (float)fr;
        rope[pos * 16 + j] = __builtin_amdgcn_cosf(f);
        rope[pos * 16 + 8 + j] = __builtin_amdgcn_sinf(f);
    }
    float* lbs = (float*)(F.ws + WS_LBS);
    for (int i = gt; i < 2 * 256; i += NT) {
        const int dir = i >> 8, c = i & 255;
        float z[DEPTH], mx = -1e30f;
#pragma unroll
        for (int l = 0; l < DEPTH; ++l) { z[l] = lb_logits[(dir * DEPTH + l) * 256 + c]; mx = fmaxf(mx, z[l]); }
        float s = 0.f;
#pragma unroll
        for (int l = 0; l < DEPTH; ++l) { z[l] = __expf(z[l] - mx); s += z[l]; }
        const float is = 1.f / s; float cum = 0.f;
#pragma unroll
        for (int l = 0; l < DEPTH; ++l) { const float p = z[l] * is; cum += p; lbs[(dir * DEPTH + l) * 256 + c] = cum - z[0] * is; }
    }
    if (gt < DEPTH) {
        const float* lp = diff_lambda + gt * 256;
        float s1 = 0.f, s2 = 0.f;
        for (int d = 0; d < 64; ++d) { s1 += lp[d] * lp[64 + d]; s2 += lp[128 + d] * lp[192 + d]; }
        const float lam_init = 0.8f - 0.6f * expf(-0.3f * (float)gt);
        ((float*)(F.ws + WS_LAM))[gt] = expf(s1) - expf(s2) + lam_init;
    }
}

template <bool GATEVAL, bool ROPEPERM = false>
__device__ __forceinline__ void transpose_item(const float* W, int K, int N, bf16_t* WT, LAS float* scr, int item, int lane, const float* gain) {
    const int nblk = N / 32, kb = item / nblk, nb = item % nblk, k0 = 64 * kb, n0 = 32 * nb;
    { float wv[32], gv[32];
#pragma unroll
      for (int i = 0; i < 32; ++i) { const int kk = 2 * i + (lane >> 5); gv[i] = gain ? gain[k0 + kk] : 1.f; wv[i] = W[(size_t)(k0 + kk) * N + n0 + (lane & 31)]; }
#pragma unroll
      for (int i = 0; i < 32; ++i) { const int kk = 2 * i + (lane >> 5); scr[kk * 33 + (lane & 31)] = wv[i] * gv[i]; } }
    LDS_WAIT(); asm volatile("" ::: "memory");
    const int c = lane & 7;
#pragma unroll
    for (int j = 0; j < 4; ++j) { const int n = (lane >> 3) + 8 * j; const LAS float* s = scr + (8 * c) * 33 + n;
        u32x4 o; o.x = cvtpk(s[0 * 33], s[1 * 33]); o.y = cvtpk(s[2 * 33], s[3 * 33]); o.z = cvtpk(s[4 * 33], s[5 * 33]); o.w = cvtpk(s[6 * 33], s[7 * 33]);
        int orow = n0 + n;
        if (ROPEPERM) { const bool rt = (orow < 2 * 256) || (orow >= 8 * 256 && orow < 12 * 256); const int p = orow & 63; if (rt && p >= 4 && p < 12) orow += (p < 8) ? 4 : -4; }
        if (GATEVAL) { const int isv = orow >= DFF, cc = isv ? orow - DFF : orow; orow = 256 * (cc >> 7) + 128 * isv + (cc & 127); }
        *(GAS u32x4*)(WT + (size_t)orow * K + k0 + 8 * c) = o; }
    LDS_WAIT(); asm volatile("" ::: "memory");
}
__device__ __forceinline__ void convert_weights(Frame& F, const float* w_in, const float* w_out, const float* w_up, const float* w_down, const float* g_in, const float* g_up) {
    const int L_tid = opaque_tid(), L_lane = L_tid & 63;
    LAS float* scr = (LAS float*)(F.lds + F.wave * 16384);
    const int gw = F.vcu * NWAVES + F.wave, NGW = F.G * NWAVES;
    constexpr int I_IN = (DM / 64) * (NIN / 32), I_OUT = (DM / 64) * (DM / 32), I_UP = (DM / 64) * (NUP / 32), I_DN = (DFF / 64) * (DM / 32);
    constexpr int NITEMS = I_IN + I_OUT + I_UP + I_DN;
    for (int it = gw; it < NITEMS; it += NGW) {
        int r = it;
        if (r < I_IN) { transpose_item<false, true>(w_in, DM, NIN, (bf16_t*)(F.ws + WS_WIN), scr, r, L_lane, g_in); continue; } r -= I_IN;
        if (r < I_OUT) { transpose_item<false>(w_out, DM, DM, (bf16_t*)(F.ws + WS_WOUT), scr, r, L_lane, nullptr); continue; } r -= I_OUT;
        if (r < I_UP) { transpose_item<true>(w_up, DM, NUP, (bf16_t*)(F.ws + WS_WUP), scr, r, L_lane, g_up); continue; } r -= I_UP;
        transpose_item<false>(w_down, DFF, DM, (bf16_t*)(F.ws + WS_WDN), scr, r, L_lane, nullptr);
    }
}

__device__ __forceinline__ void unpack8(const u32x4 b, f32x4& lo, f32x4& hi) {
    lo = (f32x4){bf2f((unsigned short)(b.x & 0xffffu)), bf2f((unsigned short)(b.x >> 16)), bf2f((unsigned short)(b.y & 0xffffu)), bf2f((unsigned short)(b.y >> 16))};
    hi = (f32x4){bf2f((unsigned short)(b.z & 0xffffu)), bf2f((unsigned short)(b.z >> 16)), bf2f((unsigned short)(b.w & 0xffffu)), bf2f((unsigned short)(b.w >> 16))};
}
__device__ __forceinline__ void init_rows(Frame& F, const float* x, bf16_t* x16, float* rs) {
    const int L_tid = opaque_tid(), L_lane = L_tid & 63;
    const int gw = F.vcu * NWAVES + F.wave, NGW = F.G * NWAVES;
    for (int m0 = gw; m0 < MTOK; m0 += 4 * NGW) {
        f32x4 v[4][4];
#pragma unroll
        for (int q = 0; q < 4; ++q) { const int m = (m0 + q * NGW < MTOK) ? m0 + q * NGW : m0; const f32x4* xr = (const f32x4*)(x + (size_t)m * DM) + 2 * L_lane;
            v[q][0] = xr[0]; v[q][1] = xr[1]; v[q][2] = xr[128]; v[q][3] = xr[129]; }
#pragma unroll
        for (int q = 0; q < 4; ++q) { const int m = m0 + q * NGW;
            float s = 0.f;
#pragma unroll
            for (int j = 0; j < 4; ++j) s += (v[q][j].x * v[q][j].x + v[q][j].y * v[q][j].y) + (v[q][j].z * v[q][j].z + v[q][j].w * v[q][j].w);
            const float r = 1.f / sqrtf(wave_sum(s) * (1.f / DM) + EPS);
            if (m < MTOK) {
                u32x4* o16 = (u32x4*)(x16 + (size_t)m * DM) + L_lane;
#pragma unroll
                for (int j = 0; j < 2; ++j) { u32x4 w; w.x = cvtpk(v[q][2 * j].x, v[q][2 * j].y); w.y = cvtpk(v[q][2 * j].z, v[q][2 * j].w); w.z = cvtpk(v[q][2 * j + 1].x, v[q][2 * j + 1].y); w.w = cvtpk(v[q][2 * j + 1].z, v[q][2 * j + 1].w); o16[64 * j] = w; }
                if (L_lane == 0) rs[m] = r;
            }
        }
    }
}
__device__ __forceinline__ void post_row_load(const bf16_t* br, const bf16_t* x16, int m, int lane, u32x4 (&b)[2], u32x4 (&xb)[2]) {
    const u32x4* brr = (const u32x4*)(br + (size_t)m * DM) + lane;
    const u32x4* xr = (const u32x4*)(x16 + (size_t)m * DM) + lane;
    b[0] = brr[0]; b[1] = brr[64]; xb[0] = xr[0]; xb[1] = xr[64];
}
__device__ __forceinline__ void post_row_finish(const u32x4 (&b)[2], const u32x4 (&xb)[2], bf16_t* x16, float* rs, float* out32, const float* gpost, int m, int lane) {
    f32x4 v[4], xv[4]; float s = 0.f;
    unpack8(b[0], v[0], v[1]); unpack8(b[1], v[2], v[3]); unpack8(xb[0], xv[0], xv[1]); unpack8(xb[1], xv[2], xv[3]);
#pragma unroll
    for (int j = 0; j < 4; ++j) s += (v[j].x * v[j].x + v[j].y * v[j].y) + (v[j].z * v[j].z + v[j].w * v[j].w);
    const float r = 1.f / sqrtf(wave_sum(s) * (1.f / DM) + EPS);
    float s2 = 0.f;
#pragma unroll
    for (int j = 0; j < 4; ++j) { const f32x4 gp = *(const f32x4*)(gpost + 8 * lane + 512 * (j >> 1) + 4 * (j & 1)); xv[j] = xv[j] + v[j] * r * gp;
        s2 += (xv[j].x * xv[j].x + xv[j].y * xv[j].y) + (xv[j].z * xv[j].z + xv[j].w * xv[j].w); }
    if (out32) {
        f32x4* xo = (f32x4*)(out32 + (size_t)m * DM) + 2 * lane;
#pragma unroll
        for (int j = 0; j < 4; ++j) xo[128 * (j >> 1) + (j & 1)] = xv[j];
    } else {
        const float r2 = 1.f / sqrtf(wave_sum(s2) * (1.f / DM) + EPS);
        u32x4* o16 = (u32x4*)(x16 + (size_t)m * DM) + lane;
#pragma unroll
        for (int j = 0; j < 2; ++j) { u32x4 w; w.x = cvtpk(xv[2 * j].x, xv[2 * j].y); w.y = cvtpk(xv[2 * j].z, xv[2 * j].w); w.z = cvtpk(xv[2 * j + 1].x, xv[2 * j + 1].y); w.w = cvtpk(xv[2 * j + 1].z, xv[2 * j + 1].w); o16[64 * j] = w; }
        if (lane == 0) rs[m] = r2;
    }
}
__device__ __forceinline__ void post_rows(Frame& F, const bf16_t* br, bf16_t* x16, float* rs, float* out32, const float* gpost) {
    const int L_tid = opaque_tid(), L_lane = L_tid & 63;
    const int gw = F.vcu * NWAVES + F.wave, NGW = F.G * NWAVES;
    for (int m = gw; m < MTOK; m += 4 * NGW) {
        u32x4 b[4][2], xx[4][2];
#pragma unroll
        for (int q = 0; q < 4; ++q) if (m + q * NGW < MTOK) post_row_load(br, x16, m + q * NGW, L_lane, b[q], xx[q]);
#pragma unroll
        for (int q = 0; q < 4; ++q) if (m + q * NGW < MTOK) post_row_finish(b[q], xx[q], x16, rs, out32, gpost, m + q * NGW, L_lane);
    }
}

__device__ __forceinline__ f32x4 ld4bf(const bf16_t* p) { const u32x2 u = *(const u32x2*)p; return (f32x4){bf2f((unsigned short)(u.x & 0xffffu)), bf2f((unsigned short)(u.x >> 16)), bf2f((unsigned short)(u.y & 0xffffu)), bf2f((unsigned short)(u.y >> 16))}; }
__device__ __forceinline__ void conv_fixup(Frame& F, const bf16_t* halo, bf16_t* act, const float* cw, const float* cb) {
    const int L_tid = opaque_tid();
    const int gt = F.vcu * (NWAVES * 64) + L_tid, NT = F.G * NWAVES * 64;
    constexpr int CG = DFF / 4, NBLK = MTOK / 64;
    constexpr int NIT = CG * NBLK * 2;
    for (int it0 = gt; it0 < NIT; it0 += 3 * NT) {
        u32x2 h[3][6]; f32x4 wv[3][8]; int rowc[3];
#pragma unroll
        for (int q = 0; q < 3; ++q) {
            const int it = (it0 + q * NT < NIT) ? it0 + q * NT : it0;
            const int cg = it % CG, rb = it / CG, blk = rb >> 1, last = rb & 1, c = cg * 4;
            rowc[q] = (blk * 64 + (last ? 63 : 0)) * DFF + c;
            const bf16_t* hc = halo + ((size_t)blk * 4 + (last ? 3 : 0)) * NUP + c;
            const bf16_t* hp = last ? halo + ((size_t)blk * 4 + 2) * NUP + c : halo + ((size_t)(blk - 1) * 4 + 3) * NUP + c;
            const bf16_t* hn = last ? halo + ((size_t)(blk + 1) * 4 + 0) * NUP + c : halo + ((size_t)blk * 4 + 1) * NUP + c;
            const bool nop = (!last) && ((blk & (SEQ / 64 - 1)) == 0), non = last && ((blk & (SEQ / 64 - 1)) == SEQ / 64 - 1);
            const u32x2 z2 = (u32x2){0u, 0u};
            h[q][0] = nop ? z2 : *(const u32x2*)hp; h[q][1] = nop ? z2 : *(const u32x2*)(hp + DFF); h[q][2] = non ? z2 : *(const u32x2*)hn; h[q][3] = non ? z2 : *(const u32x2*)(hn + DFF);
            h[q][4] = *(const u32x2*)hc; h[q][5] = *(const u32x2*)(hc + DFF);
            wv[q][0] = *(const f32x4*)(cw + c); wv[q][1] = *(const f32x4*)(cw + NUP + c); wv[q][2] = *(const f32x4*)(cw + 2 * NUP + c); wv[q][3] = *(const f32x4*)(cb + c);
            wv[q][4] = *(const f32x4*)(cw + DFF + c); wv[q][5] = *(const f32x4*)(cw + NUP + DFF + c); wv[q][6] = *(const f32x4*)(cw + 2 * NUP + DFF + c); wv[q][7] = *(const f32x4*)(cb + DFF + c);
        }
#pragma unroll
        for (int q = 0; q < 3; ++q) {
#define FX_U(u) ((f32x4){bf2f((unsigned short)((u).x & 0xffffu)), bf2f((unsigned short)((u).x >> 16)), bf2f((unsigned short)((u).y & 0xffffu)), bf2f((unsigned short)((u).y >> 16))})
            const f32x4 Gp = FX_U(h[q][0]), Vp = FX_U(h[q][1]), Gn = FX_U(h[q][2]), Vn = FX_U(h[q][3]), G = FX_U(h[q][4]), V = FX_U(h[q][5]);
#undef FX_U
            const f32x4 g = Gp * wv[q][0] + G * wv[q][1] + Gn * wv[q][2] + wv[q][3];
            const f32x4 v = Vp * wv[q][4] + V * wv[q][5] + Vn * wv[q][6] + wv[q][7];
            u32x2 w; w.x = cvtpk(g[0] / (1.f + __expf(-g[0])) * v[0], g[1] / (1.f + __expf(-g[1])) * v[1]); w.y = cvtpk(g[2] / (1.f + __expf(-g[2])) * v[2], g[3] / (1.f + __expf(-g[3])) * v[3]);
            if (it0 + q * NT < NIT) *(u32x2*)(act + (size_t)rowc[q]) = w;
        }
    }
}

constexpr int C_SLOT = 16384, C_VREG = 4 * C_SLOT, C_WSF = 8 * C_SLOT;
template <int VAR>
__device__ __forceinline__ void diffattn_unit(int bh, int qb, const bf16_t* proj, bf16_t* mixcat, LAS unsigned char* lds, const float* lamp, float outscale, const float* diff_g) {
    const int tid = opaque_tid(), lane = tid & 63, r32 = lane & 31, hi = lane >> 5; const int wid = __builtin_amdgcn_readfirstlane(tid >> 6);
    const int cmap = wid >> 2, wq = wid & 3;
    const int b = bh >> 2, h = bh & 3;
    const size_t rowbase = (size_t)b * SEQ; const int q0 = qb * 128;
    LAS float* wsf = (LAS float*)(lds + C_WSF) + wid * 128;
    bf16x8 qr[4];
    { const bf16_t* Qw = proj + (rowbase + q0 + wq * 32 + r32) * NIN + COL_QC + h * 128 + cmap * 64;
#pragma unroll
      for (int d0 = 0; d0 < 4; ++d0) qr[d0] = *(const bf16x8*)(Qw + d0 * 16 + hi * 8); }
    const bf16_t* kg = proj + (rowbase + 4 * wid + (lane >> 4)) * NIN + COL_KC + h * 128 + (((lane & 15) ^ ((4 * wid + (lane >> 4)) & 15)) * 8);
    const bf16_t* vg = proj + (rowbase + 8 * (wid >> 1) + ((lane >> 2) & 7)) * NIN + COL_VC + h * 128 + (wid & 1) * 64 + (lane >> 5) * 32 + (lane & 3) * 8;
    const int kdst = wid * 1024, vdst = C_VREG + (wid >> 1) * 2048 + (wid & 1) * 1024;
    constexpr int NT = SEQ / 64;
    const unsigned ldsb = (unsigned)(uintptr_t)lds;
#define C_GLDS(gp, ldsaddr) do { unsigned keep_; asm volatile("s_mov_b32 %0, m0\n\ts_mov_b32 m0, %2\n\ts_nop 0\n\tglobal_load_lds_dwordx4 %1, off\n\ts_mov_b32 m0, %0" \
        : "=&s"(keep_) : "v"(gp), "s"((unsigned)__builtin_amdgcn_readfirstlane((int)(ldsaddr))) : "memory"); } while (0)
#define C_DMAK(tile) do { const size_t go_ = (size_t)((tile) & (NT - 1)) * 64 * NIN; const unsigned sl_ = ldsb + ((tile) & 3) * C_SLOT + kdst; C_GLDS(kg + go_, sl_); C_GLDS(kg + go_ + 32 * NIN, sl_ + 8192); } while (0)
#define C_DMAV(tile) do { const size_t go_ = (size_t)((tile) & (NT - 1)) * 64 * NIN; const unsigned sl_ = ldsb + ((tile) & 3) * C_SLOT + vdst; C_GLDS(vg + go_, sl_); C_GLDS(vg + go_ + 32 * NIN, sl_ + 8192); } while (0)
    int kof[4];
#pragma unroll
    for (int d0 = 0; d0 < 4; ++d0) kof[d0] = r32 * 256 + (((8 * cmap + 2 * d0 + hi) ^ (r32 & 15)) * 16);
    const LAS unsigned char* vp0 = lds + C_VREG + ((lane >> 4) & 1) * 32 + (lane & 3) * 8 + (4 * hi + ((lane & 15) >> 2)) * 64;
    f32x16 o[4];
#pragma unroll
    for (int d0 = 0; d0 < 4; ++d0) o[d0] = f32x16{};
    float mrun, lrun = 0.f;
    C_DMAK(0); C_DMAV(0); C_DMAK(1); C_DMAV(1); C_DMAK(2); C_DMAV(2); C_DMAK(3);
    VM_WAIT();
    __syncthreads();
    f32x16 p0 = f32x16{}, p1 = f32x16{};
#pragma unroll
    for (int d0 = 0; d0 < 4; ++d0) {
        const bf16x8 k0 = *(const LAS bf16x8*)(lds + kof[d0]), k1 = *(const LAS bf16x8*)(lds + kof[d0] + 8192);
        p0 = MFMA32(k0, qr[d0], p0); p1 = MFMA32(k1, qr[d0], p1);
    }
    { float a = MX3(p0[0], p0[1], p1[0]), bb = MX3(p0[2], p0[3], p1[1]); a = MX3(a, p1[2], p1[3]);
#pragma unroll
      for (int r = 4; r < 16; r += 4) { a = MX3(a, p0[r], p0[r + 1]); bb = MX3(bb, p0[r + 2], p0[r + 3]); a = MX3(a, p1[r], p1[r + 1]); bb = MX3(bb, p1[r + 2], p1[r + 3]); }
      mrun = xhalf_max(__builtin_fmaxf(a, bb));
#pragma unroll
      for (int r = 0; r < 16; ++r) { p0[r] = __builtin_amdgcn_exp2f(p0[r] - mrun); p1[r] = __builtin_amdgcn_exp2f(p1[r] - mrun); } }
    bf16x8 kfe[4];
#pragma unroll
    for (int i = 0; i < 4; ++i) kfe[i] = *(const LAS bf16x8*)(lds + C_SLOT + kof[i >> 1] + (i & 1) * 8192);
    if ((VAR & 512) && wid >= 4) __builtin_amdgcn_s_sleep(8);
    for (int t = (((VAR & 64) && wid >= 4) || (VAR & 1024)) ? NT : 0; t < NT; ++t) {
        f32x16 n0, n1;
        u32x4 pw[4];
        float sacc = 0.f;
        const LAS unsigned char* kq = lds + ((t + 1) & 3) * C_SLOT;
        const LAS unsigned char* kq2 = lds + ((t + 2) & 3) * C_SLOT;
        const LAS unsigned char* vq = vp0 + (t & 3) * C_SLOT;
        bf16x8 kf[8], vf[8];
#pragma unroll
        for (int i = 0; i < 4; ++i) kf[i] = kfe[i];
#pragma unroll
        for (int i = 4; i < 8; ++i) kf[i] = *(const LAS bf16x8*)(kq + kof[i >> 1] + (i & 1) * 8192);
#define C_VFRAG(i) cat8(vtr(vq + ((i) >> 2) * 4096 + ((i) & 3) * 512), vtr(vq + ((i) >> 2) * 4096 + ((i) & 3) * 512 + 2048))
#define C_GA(i, ACC, FIRST, PP, B) do { \
            vf[i] = C_VFRAG(i); \
            if (!(VAR & 32)) { ACC = FIRST ? MFMA32(kf[i], qr[(i) >> 1], f32x16{}) : MFMA32(kf[i], qr[(i) >> 1], ACC); } else if (FIRST) { ACC = f32x16{}; ACC[0] = __builtin_bit_cast(float, (int)kf[i][0]); } \
            if (!(VAR & 4)) { sacc += PP[B]; sacc += PP[B + 1]; sacc += PP[B + 2]; sacc += PP[B + 3]; asm volatile("" : "+v"(sacc)); \
            pw[(i) >> 1][2 * ((i) & 1)] = cvtpk(PP[B], PP[B + 1]); pw[(i) >> 1][2 * ((i) & 1) + 1] = cvtpk(PP[B + 2], PP[B + 3]); asm volatile("" : "+v"(pw[(i) >> 1])); } \
            else { pw[(i) >> 1][2 * ((i) & 1)] = __builtin_bit_cast(unsigned, PP[B]); pw[(i) >> 1][2 * ((i) & 1) + 1] = __builtin_bit_cast(unsigned, PP[B + 2]); } \
            __builtin_amdgcn_sched_barrier(0); } while (0)
        C_GA(0, n0, true, p0, 0);  C_GA(1, n1, true, p0, 4);  C_GA(2, n0, false, p0, 8); C_GA(3, n1, false, p0, 12);
        C_GA(4, n0, false, p1, 0); C_GA(5, n1, false, p1, 4); C_GA(6, n0, false, p1, 8); C_GA(7, n1, false, p1, 12);
#undef C_GA
        lrun += sacc;
        if (!(VAR & 1)) { C_DMAK(t + 4); C_DMAV(t + 3); }
        float mxa, mxb;
#define C_GB(i) do { \
            o[(i) & 3] = MFMA32(__builtin_bit_cast(bf16x8, pw[(i) >> 2]), vf[(i) & 7], o[(i) & 3]); \
            if ((i) < 8) vf[(i) & 7] = C_VFRAG((i) + 8); \
            if ((i) >= 8 && (i) < 12) kfe[(i) - 8] = *(const LAS bf16x8*)(kq2 + kof[((i) - 8) >> 1] + (((i) - 8) & 1) * 8192); \
            if ((i) < 4) { const int c_ = 4 * (i); \
                if ((i) == 0) { mxa = MX3(n0[0], n0[1], n1[0]); mxb = MX3(n0[2], n0[3], n1[1]); mxa = MX3(mxa, n1[2], n1[3]); } \
                else { mxa = MX3(mxa, n0[c_], n0[c_ + 1]); mxb = MX3(mxb, n0[c_ + 2], n0[c_ + 3]); mxa = MX3(mxa, n1[c_], n1[c_ + 1]); mxb = MX3(mxb, n1[c_ + 2], n1[c_ + 3]); } \
                asm volatile("" : "+v"(mxa), "+v"(mxb)); } \
            __builtin_amdgcn_sched_barrier(0); } while (0)
#define C_EX(e) do { float e0 = (VAR & 2) ? n0[e] : __builtin_amdgcn_exp2f(n0[e] - mnew), e1 = (VAR & 2) ? n1[e] : __builtin_amdgcn_exp2f(n1[e] - mnew); asm volatile("" : "+v"(e0), "+v"(e1)); p0[e] = e0; p1[e] = e1; } while (0)
#define C_GBX(i, ea, eb) do { \
            o[(i) & 3] = MFMA32(__builtin_bit_cast(bf16x8, pw[(i) >> 2]), vf[(i) & 7], o[(i) & 3]); \
            if ((i) < 8) vf[(i) & 7] = C_VFRAG((i) + 8); \
            if ((i) >= 8 && (i) < 12) kfe[(i) - 8] = *(const LAS bf16x8*)(kq2 + kof[((i) - 8) >> 1] + (((i) - 8) & 1) * 8192); \
            C_EX(ea); if ((eb) >= 0) C_EX((eb) < 0 ? 0 : (eb)); \
            __builtin_amdgcn_sched_barrier(0); } while (0)
        C_GB(0); C_GB(1); C_GB(2); C_GB(3);
        const float rm = xhalf_max(__builtin_fmaxf(mxa, mxb));
        const float mnew = __builtin_fmaxf(mrun, rm);
        const float al = __builtin_amdgcn_exp2f(mrun - mnew);
        const bool need = __any(mnew > mrun);
        mrun = mnew; lrun *= al;
        __builtin_amdgcn_sched_barrier(0);
        C_GBX(4, 0, 1); C_GBX(5, 2, 3); C_GBX(6, 4, 5); C_GBX(7, 6, 7);
        C_GBX(8, 8, -1); C_GBX(9, 9, -1); C_GBX(10, 10, -1); C_GBX(11, 11, -1); C_GBX(12, 12, -1); C_GBX(13, 13, -1); C_GBX(14, 14, -1); C_GBX(15, 15, -1);
#undef C_GBX
#undef C_EX
#undef C_GB
#undef C_VFRAG
        if (need) {
            if (hi == 0) wsf[r32] = al;
            LDS_WAIT();
#pragma unroll
            for (int g = 0; g < 4; ++g) { const f32x4 a4 = *(const LAS f32x4*)(wsf + 8 * g + 4 * hi);
#pragma unroll
                for (int d0 = 0; d0 < 4; ++d0)
#pragma unroll
                    for (int j = 0; j < 4; ++j) o[d0][4 * g + j] *= a4[j]; }
        }
        asm volatile("s_waitcnt vmcnt(4)" ::: "memory");
        if (!(VAR & 8)) __syncthreads();
    }
    VM_WAIT();
    __syncthreads();
#undef C_DMAK
#undef C_DMAV
#undef C_GLDS
    { const float lt = xhalf_sum(lrun);
      const float sc = (cmap ? *lamp : 1.f) / lt;
      if (hi == 0) wsf[r32] = sc;
      LDS_WAIT();
      LAS float* xb = (LAS float*)(lds + wq * 16384) + lane;
#pragma unroll
      for (int g = 0; g < 4; ++g) { const f32x4 s4 = *(const LAS f32x4*)(wsf + 8 * g + 4 * hi);
#pragma unroll
          for (int d0 = 0; d0 < 4; ++d0)
#pragma unroll
              for (int j = 0; j < 4; ++j) o[d0][4 * g + j] *= s4[j]; }
      if (cmap == 1) {
#pragma unroll
          for (int d0 = 0; d0 < 4; ++d0)
#pragma unroll
              for (int rr = 0; rr < 16; ++rr) xb[(d0 * 16 + rr) * 64] = o[d0][rr];
      }
      __syncthreads();
      if (cmap == 0) {
          float gd[4];
#pragma unroll
          for (int d0 = 0; d0 < 4; ++d0) gd[d0] = diff_g[32 * d0 + r32] * outscale;
          bf16_t* Ow = mixcat + (rowbase + q0 + wq * 32) * DM + 512 + h * 128 + r32;
#pragma unroll
          for (int rr = 0; rr < 16; ++rr) {
              float v[4], ss = 0.f;
#pragma unroll
              for (int d0 = 0; d0 < 4; ++d0) { v[d0] = o[d0][rr] - xb[(d0 * 16 + rr) * 64]; ss += v[d0] * v[d0]; }
#pragma unroll
              for (int s = 1; s < 32; s <<= 1) ss += __shfl_xor(ss, s);
              const float rs = 1.f / sqrtf(ss * (1.f / 128.f) + EPS);
              const int row = crow(rr, hi);
#pragma unroll
              for (int d0 = 0; d0 < 4; ++d0) Ow[(size_t)row * DM + 32 * d0] = f2bf1(v[d0] * rs * gd[d0]);
          }
      }
      __syncthreads();
    }
}
template <int VAR>
__device__ __forceinline__ void diffattn_phase(Frame& F, const bf16_t* proj, bf16_t* mixcat, const float* lamp, float outscale, const float* diff_g) {
    for (int u = F.vcu; u < BATCH * 4 * (SEQ / 128); u += F.G) diffattn_unit<VAR>(u >> 6, u & 63, proj, mixcat, F.lds, lamp, outscale, diff_g);
}

constexpr int A_OST = 0, A_ML = 65536, A_WV = 69632, A_WVB = 8704;
template <int D, bool FIRST, bool LAST, int VAR = 0>
__device__ __forceinline__ void dilated_task(int b, int h, int P0, int j, const bf16_t* proj, bf16_t* mixcat, LAS unsigned char* lds, LAS unsigned char* wlds) {
    const int lane = opaque_tid() & 63, r32 = lane & 31, hi = lane >> 5;
    constexpr int NB = 16 / D, L = SEQ / D;
    const int rho = j / NB, blk = j % NB;
    const int lb0 = P0 / D + 32 * blk;
    const size_t rowbase = (size_t)b * SEQ;
    LAS float* wsf = (LAS float*)(wlds + 4096);
    LAS float* mst = (LAS float*)(lds + A_ML); LAS float* lst = mst + 512;
    const int plq = (32 * blk + r32) * D + rho;
    const int plo = (32 * blk + 4 * hi) * D + rho;
    LAS unsigned char* ktile = wlds + 4608;
    const int kwr = (lane >> 3) * 128 + (((lane & 7) ^ ((lane >> 3) & 7)) * 16);
    int kfo[4];
#pragma unroll
    for (int d0 = 0; d0 < 4; ++d0) kfo[d0] = r32 * 128 + (((2 * d0 + hi) ^ (r32 & 7)) * 16);
    bf16x8 qr[4];
    { const bf16_t* Qg = proj + (rowbase + ((VAR & 1) ? 0 : P0 + (32 * blk + (lane >> 3)) * D + rho)) * ((VAR & 8) ? 768 : NIN) + COL_QA + h * 64 + (lane & 7) * 8;
      u32x4 qs[4];
#pragma unroll
      for (int j = 0; j < 4; ++j) qs[j] = *(const u32x4*)(Qg + (size_t)((VAR & 1) ? 0 : 8 * j * D) * ((VAR & 8) ? 768 : NIN));
#pragma unroll
      for (int j = 0; j < 4; ++j) *(LAS u32x4*)(ktile + kwr + j * 1024) = qs[j];
      LDS_WAIT();
#pragma unroll
      for (int d0 = 0; d0 < 4; ++d0) qr[d0] = *(const LAS bf16x8*)(ktile + kfo[d0]);
      LDS_WAIT(); }
    const bf16_t* Kb = proj + (rowbase + rho) * NIN + COL_KA + h * 64 + (lane & 7) * 8;
    const bf16_t* Vb = proj + (rowbase + rho) * NIN + COL_VA + h * 64 + (lane & 7) * 8;
    f32x16 o[2]; float mrun, lrun;
    if (FIRST || (VAR & 4)) { o[0] = f32x16{}; o[1] = f32x16{}; mrun = -1e30f; lrun = 0.f; }
    else {
        mrun = mst[plq]; lrun = hi ? 0.f : lst[plq];
#pragma unroll
        for (int d0 = 0; d0 < 2; ++d0)
#pragma unroll
            for (int rr = 0; rr < 16; ++rr) o[d0][rr] = bf2f(*(const LAS bf16_t*)(lds + A_OST + (plo + ((rr & 3) + 8 * (rr >> 2)) * D) * 128 + (32 * d0 + r32) * 2));
    }
    u32x4 kst[3][4], vst[2][4];
    const int vw = ((lane & 7) >> 2) * 2048 + (lane >> 3) * 64 + (lane & 3) * 16;
    const LAS unsigned char* vp0 = wlds + ((lane >> 4) & 1) * 32 + (lane & 3) * 8 + (4 * hi + ((lane & 15) >> 2)) * 64;
#pragma unroll
#define A_LOADK(kb, S) do { _Pragma("unroll") for (int j = 0; j < 4; ++j) { int lk = lb0 - 64 + 32 * (kb) + (lane >> 3) + 8 * j; lk = lk < 0 ? 0 : (lk >= L ? L - 1 : lk); \
            kst[S][j] = *(const u32x4*)(Kb + (size_t)((VAR & 1) ? 0 : lk * D) * ((VAR & 8) ? 768 : NIN)); } } while (0)
    A_LOADK(0, 0); A_LOADK(1, 1); A_LOADK(2, 2);
#define A_LOADV(kb, S) do { _Pragma("unroll") for (int q = 0; q < 4; ++q) { int lk = lb0 - 64 + 32 * (kb) + (lane >> 3) + 8 * q; lk = lk < 0 ? 0 : (lk >= L ? L - 1 : lk); \
          vst[S][q] = *(const u32x4*)(Vb + (size_t)((VAR & 1) ? 0 : lk * D) * ((VAR & 8) ? 768 : NIN)); } } while (0)
    A_LOADV(0, 0); A_LOADV(1, 1);
    __builtin_amdgcn_sched_barrier(0);
    f32x16 p[5];
    float mx = -1e30f;
#pragma unroll
    for (int kb = 0; kb < 5; ++kb) {
        f32x16 acc = f32x16{};
#pragma unroll
        for (int j = 0; j < 4; ++j) *(LAS u32x4*)(ktile + kwr + j * 1024) = kst[kb % 3][j];
        if (kb + 3 < 5) A_LOADK(kb + 3, kb % 3);
        LDS_WAIT();
#pragma unroll
        for (int d0 = 0; d0 < 4; ++d0) { const bf16x8 kf = *(const LAS bf16x8*)(ktile + kfo[d0]); if (!(VAR & 2)) acc = MFMA32(kf, qr[d0], acc); else acc[d0] += __builtin_bit_cast(float, (int)kf[0]) + __builtin_bit_cast(float, (int)qr[d0][0]); }
        LDS_WAIT();
        const int lk0 = lb0 - 64 + 32 * kb;
        const int rel = 64 - 32 * kb + r32;
        int klo = rel - 64, khi = rel + 64;
        klo = klo > -lk0 ? klo : -lk0; khi = khi < L - 1 - lk0 ? khi : L - 1 - lk0;
        const unsigned span = (unsigned)(khi - klo);
        const int t0 = 4 * hi - klo;
        const bool any_ok = khi >= klo;
#pragma unroll
        for (int rr = 0; rr < 16; ++rr) { const int kk = (rr & 3) + 8 * (rr >> 2);
            const bool ok = any_ok && ((unsigned)(kk + t0) <= span);
            acc[rr] = ok ? acc[rr] : -__builtin_inff(); mx = __builtin_fmaxf(mx, acc[rr]); }
        p[kb] = acc;
    }
    const float rm = xhalf_max(mx);
    const float mnew = __builtin_fmaxf(mrun, rm);
    const float al = __builtin_amdgcn_exp2f(mrun - mnew);
    mrun = mnew;
    float ls = 0.f;
    u32x4 pw[5][2];
#pragma unroll
    for (int kb = 0; kb < 5; ++kb) {
#pragma unroll
        for (int rr = 0; rr < 16; ++rr) { p[kb][rr] = __builtin_amdgcn_exp2f(p[kb][rr] - mnew); ls += p[kb][rr]; }
        pw[kb][0] = (u32x4){cvtpk(p[kb][0], p[kb][1]), cvtpk(p[kb][2], p[kb][3]), cvtpk(p[kb][4], p[kb][5]), cvtpk(p[kb][6], p[kb][7])};
        pw[kb][1] = (u32x4){cvtpk(p[kb][8], p[kb][9]), cvtpk(p[kb][10], p[kb][11]), cvtpk(p[kb][12], p[kb][13]), cvtpk(p[kb][14], p[kb][15])};
    }
    lrun = lrun * al + ls;
    if (!FIRST) {
        if (hi == 0) wsf[r32] = al;
        LDS_WAIT();
#pragma unroll
        for (int g = 0; g < 4; ++g) { const f32x4 a4 = *(const LAS f32x4*)(wsf + 8 * g + 4 * hi);
#pragma unroll
            for (int d0 = 0; d0 < 2; ++d0)
#pragma unroll
                for (int q = 0; q < 4; ++q) o[d0][4 * g + q] *= a4[q]; }
    }
#pragma unroll
    for (int kb = 0; kb < 5; ++kb) {
#pragma unroll
        for (int q = 0; q < 4; ++q) *(LAS u32x4*)(wlds + vw + q * 512) = vst[kb & 1][q];
        if (kb + 2 < 5) A_LOADV(kb + 2, kb & 1);
        LDS_WAIT();
#pragma unroll
        for (int d0 = 0; d0 < 2; ++d0) {
            const bf16x8 vf0 = cat8(vtr(vp0 + d0 * 2048), vtr(vp0 + d0 * 2048 + 512));
            const bf16x8 vf1 = cat8(vtr(vp0 + d0 * 2048 + 1024), vtr(vp0 + d0 * 2048 + 1536));
            if (!(VAR & 2)) { o[d0] = MFMA32(__builtin_bit_cast(bf16x8, pw[kb][0]), vf0, o[d0]);
            o[d0] = MFMA32(__builtin_bit_cast(bf16x8, pw[kb][1]), vf1, o[d0]); } else { o[d0][0] += __builtin_bit_cast(float, (int)vf0[0]) + __builtin_bit_cast(float, (int)vf1[1]) + __builtin_bit_cast(float, pw[kb][0].x); }
        }
        LDS_WAIT();
    }
#undef A_LOADV
#undef A_LOADK
    const float lt = xhalf_sum(lrun);
    if (VAR & 4) { if (lt == 12345.f) mst[plq] = o[0][0] + o[1][3]; }
    else if (!LAST) {
        if (hi == 0) { mst[plq] = mrun; lst[plq] = lt; }
#pragma unroll
        for (int d0 = 0; d0 < 2; ++d0)
#pragma unroll
            for (int rr = 0; rr < 16; ++rr) *(LAS bf16_t*)(lds + A_OST + (plo + ((rr & 3) + 8 * (rr >> 2)) * D) * 128 + (32 * d0 + r32) * 2) = f2bf1(o[d0][rr]);
    } else {
        if (hi == 0) wsf[r32] = 1.f / lt;
        LDS_WAIT();
        bf16_t* Ow = mixcat + (rowbase + P0 + plo) * DM + h * 64 + r32;
#pragma unroll
        for (int g = 0; g < 4; ++g) { const f32x4 i4 = *(const LAS f32x4*)(wsf + 8 * g + 4 * hi);
#pragma unroll
            for (int q = 0; q < 4; ++q) { const int row = (q + 8 * g) * D;
#pragma unroll
                for (int d0 = 0; d0 < 2; ++d0) Ow[(size_t)row * DM + 32 * d0] = f2bf1(o[d0][4 * g + q] * i4[q]); } }
        LDS_WAIT();
    }
}
template <int VAR = 0>
__device__ __forceinline__ void dilated_phase(Frame& F, const bf16_t* proj, bf16_t* mixcat) {
    LAS unsigned char* wlds = F.lds + A_WV + F.wave * A_WVB;
    for (int c = F.vcu; c < BATCH * 4 * (SEQ / 512); c += F.G) {
        const int bh = c >> 4, b = bh >> 2, h = bh & 3, P0 = (c & 15) * 512;
        dilated_task<16, true, false, VAR>(b, h, P0, F.wave, proj, mixcat, F.lds, wlds);
        dilated_task<16, true, false, VAR>(b, h, P0, F.wave + 8, proj, mixcat, F.lds, wlds);
        __syncthreads();
        dilated_task<4, false, false, VAR>(b, h, P0, F.wave, proj, mixcat, F.lds, wlds);
        dilated_task<4, false, false, VAR>(b, h, P0, F.wave + 8, proj, mixcat, F.lds, wlds);
        __syncthreads();
        dilated_task<1, false, true, VAR>(b, h, P0, F.wave, proj, mixcat, F.lds, wlds);
        dilated_task<1, false, true, VAR>(b, h, P0, F.wave + 8, proj, mixcat, F.lds, wlds);
        __syncthreads();
    }
}

constexpr int HB_PITCH = 144;
constexpr int HB_QT = 0, HB_KT = 32 * HB_PITCH, HB_VT = 2 * 32 * HB_PITCH, HB_SC = HB_VT + 4096, HB_WAVE = 14336;
template <bool WITH_OUT>
__device__ __forceinline__ void hgrn_task(int task, int layer, const bf16_t* proj, const float* lbs, bf16_t* hs, float* hd, bf16_t* ho, LAS unsigned char* wl) {
    const int lane = opaque_tid() & 63, r32 = lane & 31, hi = lane >> 5;
    const int sc = task & 63, chain = task >> 6, dir = chain & 1, h = (chain >> 1) & 3, b = chain >> 3;
    const size_t rowbase = (size_t)b * SEQ;
    const float lb = lbs[(dir * DEPTH + layer) * 256 + h * 64 + lane];
    const float oml = 1.f - lb;
    const int zcol = (dir ? COL_FZB : COL_FZF) + h * 64 + lane;
    LAS float* scr = (LAS float*)(wl + HB_SC);
    f32x16 S[2][2];
#pragma unroll
    for (int mb = 0; mb < 2; ++mb)
#pragma unroll
        for (int vb = 0; vb < 2; ++vb) {
            if (WITH_OUT) {
                const bf16_t* sp = hs + (size_t)task * 4096 + (32 * mb + 4 * hi) * 64 + 32 * vb + r32;
#pragma unroll
                for (int rr = 0; rr < 16; ++rr) S[mb][vb][rr] = bf2f(sp[((rr & 3) + 8 * (rr >> 2)) * 64]);
            } else S[mb][vb] = f32x16{};
        }
    float atot = 0.f;
    const LAS unsigned char* vpP = wl + HB_VT + ((lane >> 4) & 1) * 32 + (lane & 3) * 8 + (4 * hi + ((lane & 15) >> 2)) * 64;
    const LAS unsigned char* vpN = wl + HB_VT + ((lane >> 4) & 1) * 32 + (lane & 3) * 8 + (8 * hi + ((lane & 15) >> 2)) * 64;
    for (int ck = 0; ck < 4; ++ck) {
        const int tau0 = sc * 128 + ck * 32;
        const long pstep = dir ? -(long)NIN : (long)NIN;
        const bf16_t* row0 = proj + (rowbase + (dir ? (SEQ - 1 - tau0) : tau0)) * NIN;
        { const int sr = lane >> 3, gc = (lane & 7) * 8;
          u32x4 zr[4], qw[4], vr[4];
#pragma unroll
          for (int j = 0; j < 4; ++j) { const bf16_t* rp = row0 + (long)(sr + 8 * j) * pstep + h * 64 + gc;
              zr[j] = *(const u32x4*)(rp + (dir ? COL_FZB : COL_FZF)); vr[j] = *(const u32x4*)(rp + COL_IB); if (WITH_OUT) qw[j] = *(const u32x4*)(rp + COL_QB); }
#pragma unroll
          for (int j = 0; j < 4; ++j) { const int s = sr + 8 * j;
              *(LAS u32x4*)(wl + HB_KT + s * 128 + (lane & 7) * 16) = zr[j];
              if (WITH_OUT) *(LAS u32x4*)(wl + HB_QT + s * 128 + (lane & 7) * 16) = qw[j];
              *(LAS u32x4*)(wl + HB_VT + ((lane & 7) >> 2) * 2048 + s * 64 + (lane & 3) * 16) = vr[j]; } }
        LDS_WAIT();
        float a[32], kk[32];
        { float run = 0.f;
#pragma unroll
          for (int s = 0; s < 32; ++s) {
              const float z = bf2f(*(const LAS bf16_t*)(wl + HB_KT + s * 128 + lane * 2));
              const float e = __expf(-z);
              const float sig = __builtin_amdgcn_rcpf(1.f + e);
              const float f = lb + oml * sig;
              run += __logf(f);
              a[s] = run;
              kk[s] = oml * (1.f - sig);
          } }
        const float alast = a[31], aref = a[15];
        atot += alast;
        scr[lane] = __expf(alast); scr[64 + lane] = __expf(aref);
        const float ela = __expf(alast - aref);
        float e2v[32];
#pragma unroll
        for (int s = 0; s < 32; ++s) { const float e1 = __expf(fminf(fmaxf(a[s] - aref, -80.f), 80.f)); e2v[s] = __builtin_amdgcn_rcpf(e1); if (WITH_OUT) a[s] = e1; }
        bf16x8 kA[2][2];
#pragma unroll
        for (int ks = 0; ks < 2; ++ks) {
            u32x4 x0, x1;
#pragma unroll
            for (int q = 0; q < 4; ++q) {
                const int s0 = 16 * ks + 2 * q, s1 = 16 * ks + 8 + 2 * q;
                x0[q] = cvtpk(kk[s0] * e2v[s0] * ela, kk[s0 + 1] * e2v[s0 + 1] * ela);
                x1[q] = cvtpk(kk[s1] * e2v[s1] * ela, kk[s1 + 1] * e2v[s1 + 1] * ela);
            }
            u32x4 f0, f1;
#pragma unroll
            for (int q = 0; q < 4; ++q) { auto rr = __builtin_amdgcn_permlane32_swap(x0[q], x1[q], false, false); f0[q] = rr[0]; f1[q] = rr[1]; }
            kA[0][ks] = __builtin_bit_cast(bf16x8, f0); kA[1][ks] = __builtin_bit_cast(bf16x8, f1);
        }
        if (WITH_OUT) {
            float qc[32];
#pragma unroll
            for (int s = 0; s < 32; ++s) qc[s] = bf2f(*(const LAS bf16_t*)(wl + HB_QT + s * 128 + lane * 2));
            LDS_WAIT();
#pragma unroll
            for (int s = 0; s < 32; ++s) {
                *(LAS bf16_t*)(wl + HB_QT + s * HB_PITCH + lane * 2) = f2bf1(qc[s] * a[s]);
                *(LAS bf16_t*)(wl + HB_KT + s * HB_PITCH + lane * 2) = f2bf1(kk[s] * e2v[s]);
            }
        }
        LDS_WAIT();
        f32x16 O[2];
        if (WITH_OUT) {
            f32x16 p = f32x16{};
#pragma unroll
            for (int kd = 0; kd < 4; ++kd) {
                const bf16x8 kf = *(const LAS bf16x8*)(wl + HB_KT + r32 * HB_PITCH + kd * 32 + hi * 16);
                const bf16x8 qf = *(const LAS bf16x8*)(wl + HB_QT + r32 * HB_PITCH + kd * 32 + hi * 16);
                p = MFMA32(kf, qf, p);
            }
#pragma unroll
            for (int rr = 0; rr < 16; ++rr) { const int s = (rr & 3) + 8 * (rr >> 2) + 4 * hi; p[rr] = (s <= r32) ? p[rr] : 0.f; }
            const u32x4 pw0 = (u32x4){cvtpk(p[0], p[1]), cvtpk(p[2], p[3]), cvtpk(p[4], p[5]), cvtpk(p[6], p[7])};
            const u32x4 pw1 = (u32x4){cvtpk(p[8], p[9]), cvtpk(p[10], p[11]), cvtpk(p[12], p[13]), cvtpk(p[14], p[15])};
#pragma unroll
            for (int vb = 0; vb < 2; ++vb) {
                const bf16x8 vf0 = cat8(vtr(vpP + vb * 2048), vtr(vpP + vb * 2048 + 512));
                const bf16x8 vf1 = cat8(vtr(vpP + vb * 2048 + 1024), vtr(vpP + vb * 2048 + 1536));
                O[vb] = MFMA32(__builtin_bit_cast(bf16x8, pw0), vf0, f32x16{});
                O[vb] = MFMA32(__builtin_bit_cast(bf16x8, pw1), vf1, O[vb]);
            }
#pragma unroll
            for (int mb = 0; mb < 2; ++mb)
#pragma unroll
                for (int sp = 0; sp < 2; ++sp) {
                    const f32x4 e0 = *(const LAS f32x4*)(scr + 64 + 32 * mb + 16 * sp + 4 * hi), e1 = *(const LAS f32x4*)(scr + 64 + 32 * mb + 16 * sp + 8 + 4 * hi);
                    const u32x2 qa = *(const LAS u32x2*)(wl + HB_QT + r32 * HB_PITCH + (32 * mb + 16 * sp + 4 * hi) * 2);
                    const u32x2 qb = *(const LAS u32x2*)(wl + HB_QT + r32 * HB_PITCH + (32 * mb + 16 * sp + 8 + 4 * hi) * 2);
                    const bf16x8 qf = __builtin_bit_cast(bf16x8, (u32x4){qa.x, qa.y, qb.x, qb.y});
#pragma unroll
                    for (int vb = 0; vb < 2; ++vb) {
                        const f32x16& X = S[mb][vb];
                        const u32x4 sw = (u32x4){cvtpk(X[8 * sp] * e0[0], X[8 * sp + 1] * e0[1]), cvtpk(X[8 * sp + 2] * e0[2], X[8 * sp + 3] * e0[3]),
                                                 cvtpk(X[8 * sp + 4] * e1[0], X[8 * sp + 5] * e1[1]), cvtpk(X[8 * sp + 6] * e1[2], X[8 * sp + 7] * e1[3])};
                        O[vb] = MFMA32(qf, __builtin_bit_cast(bf16x8, sw), O[vb]);
                    }
                }
            bf16_t* op = ho + ((size_t)dir * MTOK + rowbase) * 256 + h * 64 + r32;
#pragma unroll
            for (int vb = 0; vb < 2; ++vb)
#pragma unroll
                for (int rr = 0; rr < 16; ++rr) { const int t = (rr & 3) + 8 * (rr >> 2) + 4 * hi; const int pos = dir ? (SEQ - 1 - (tau0 + t)) : (tau0 + t);
                    op[(size_t)pos * 256 + 32 * vb] = f2bf1(O[vb][rr]); }
        }
#pragma unroll
        for (int mb = 0; mb < 2; ++mb) {
#pragma unroll
            for (int g = 0; g < 4; ++g) { const f32x4 e4 = *(const LAS f32x4*)(scr + 32 * mb + 8 * g + 4 * hi);
#pragma unroll
                for (int vb = 0; vb < 2; ++vb)
#pragma unroll
                    for (int j = 0; j < 4; ++j) S[mb][vb][4 * g + j] *= e4[j]; }
        }
#pragma unroll
        for (int vb = 0; vb < 2; ++vb)
#pragma unroll
            for (int ks = 0; ks < 2; ++ks) {
                const bf16x8 vf = cat8(vtr(vpN + vb * 2048 + ks * 1024), vtr(vpN + vb * 2048 + ks * 1024 + 256));
                S[0][vb] = MFMA32(kA[0][ks], vf, S[0][vb]);
                S[1][vb] = MFMA32(kA[1][ks], vf, S[1][vb]);
            }
        LDS_WAIT();
    }
    if (!WITH_OUT) {
        hd[(size_t)task * 64 + lane] = __expf(atot);
#pragma unroll
        for (int mb = 0; mb < 2; ++mb)
#pragma unroll
            for (int vb = 0; vb < 2; ++vb) { bf16_t* sp = hs + (size_t)task * 4096 + (32 * mb + 4 * hi) * 64 + 32 * vb + r32;
#pragma unroll
                for (int rr = 0; rr < 16; ++rr) sp[((rr & 3) + 8 * (rr >> 2)) * 64] = f2bf1(S[mb][vb][rr]); }
    }
}
template <bool WITH_OUT>
__device__ __forceinline__ void hgrn_phase(Frame& F, int layer, const bf16_t* proj) {
    const int L_tid = opaque_tid(), L_lane = L_tid & 63;
    const int gw = F.vcu * NWAVES + F.wave, NGW = F.G * NWAVES;
    LAS unsigned char* wl = F.lds + F.wave * HB_WAVE;
    for (int task = gw; task < 32 * 64; task += NGW)
        hgrn_task<WITH_OUT>(task, layer, proj, (const float*)(F.ws + WS_LBS), (bf16_t*)(F.ws + WS_HS), (float*)(F.ws + WS_HD), (bf16_t*)(F.ws + WS_HO), wl);
}
__device__ __forceinline__ void hgrn_scan(Frame& F) {
    const int L_tid = opaque_tid(), L_lane = L_tid & 63;
    const int gt = F.vcu * (NWAVES * 64) + L_tid, NT = F.G * NWAVES * 64;
    bf16_t* hs = (bf16_t*)(F.ws + WS_HS); const float* hd = (const float*)(F.ws + WS_HD);
    for (int e = gt; e < 32 * 4096; e += NT) {
        const int chain = e >> 12, dv = e & 4095, d = dv >> 6;
        float s = 0.f;
        bf16_t* p = hs + (size_t)chain * 64 * 4096 + dv; const float* dp = hd + (size_t)chain * 64 * 64 + d;
#pragma unroll
        for (int jb = 0; jb < 64; jb += 32) {
            unsigned short loc[32]; float dec[32];
#pragma unroll
            for (int j = 0; j < 32; ++j) { loc[j] = p[(size_t)(jb + j) * 4096]; dec[j] = dp[(jb + j) * 64]; }
#pragma unroll
            for (int j = 0; j < 32; ++j) { p[(size_t)(jb + j) * 4096] = f2bf1(s); s = dec[j] * s + bf2f(loc[j]); }
        }
    }
}
__device__ __forceinline__ void hgrn_combine(Frame& F, const bf16_t* proj, const float* hg, bf16_t* mixcat) {
    const int L_tid = opaque_tid(), L_lane = L_tid & 63;
    const int gw = F.vcu * NWAVES + F.wave, NGW = F.G * NWAVES;
    const bf16_t* ho = (const bf16_t*)(F.ws + WS_HO);
    const f32x4 g4 = *(const f32x4*)(hg + (L_lane & 15) * 4);
    for (int m0 = gw; m0 < MTOK; m0 += 4 * NGW) {
        u32x2 uf[4], ub[4], gz[4];
#pragma unroll
        for (int q = 0; q < 4; ++q) { const int m = (m0 + q * NGW < MTOK) ? m0 + q * NGW : m0;
            uf[q] = *(const u32x2*)(ho + (size_t)m * 256 + L_lane * 4); ub[q] = *(const u32x2*)(ho + ((size_t)MTOK + m) * 256 + L_lane * 4); gz[q] = *(const u32x2*)(proj + (size_t)m * NIN + COL_GB + L_lane * 4); }
#pragma unroll
        for (int q = 0; q < 4; ++q) { const int m = m0 + q * NGW;
            const f32x4 of = (f32x4){bf2f((unsigned short)(uf[q].x & 0xffffu)), bf2f((unsigned short)(uf[q].x >> 16)), bf2f((unsigned short)(uf[q].y & 0xffffu)), bf2f((unsigned short)(uf[q].y >> 16))};
            const f32x4 ob = (f32x4){bf2f((unsigned short)(ub[q].x & 0xffffu)), bf2f((unsigned short)(ub[q].x >> 16)), bf2f((unsigned short)(ub[q].y & 0xffffu)), bf2f((unsigned short)(ub[q].y >> 16))};
            const f32x4 v = of + ob;
            float ss = (v.x * v.x + v.y * v.y) + (v.z * v.z + v.w * v.w);
            ss += __shfl_xor(ss, 1); ss += __shfl_xor(ss, 2); ss += __shfl_xor(ss, 4); ss += __shfl_xor(ss, 8);
            const float r = 1.f / sqrtf(ss * (1.f / 64.f) + EPS);
            const float z0 = bf2f((unsigned short)(gz[q].x & 0xffffu)), z1 = bf2f((unsigned short)(gz[q].x >> 16)), z2 = bf2f((unsigned short)(gz[q].y & 0xffffu)), z3 = bf2f((unsigned short)(gz[q].y >> 16));
            const float s0 = z0 / (1.f + __expf(-z0)), s1 = z1 / (1.f + __expf(-z1)), s2 = z2 / (1.f + __expf(-z2)), s3 = z3 / (1.f + __expf(-z3));
            u32x2 w; w.x = cvtpk(v.x * r * g4.x * s0, v.y * r * g4.y * s1); w.y = cvtpk(v.z * r * g4.z * s2, v.w * r * g4.w * s3);
            if (m < MTOK) *(u32x2*)(mixcat + (size_t)m * DM + 256 + L_lane * 4) = w; }
    }
}

struct Args { const float* in[15]; float* out; unsigned char* ws; };
typedef __attribute__((address_space(4))) const Args CArgs;
__device__ __forceinline__ CArgs* kargs() { auto p = __builtin_amdgcn_kernarg_segment_ptr(); asm volatile("" : "+s"(p)); return (CArgs*)p; }
#define AIN(i) (kargs()->in[(i)])
__global__ void __launch_bounds__(NWAVES * 64, 2) fwd_kernel(Args args) {
    extern __shared__ __attribute__((aligned(16))) unsigned char lds[];
    Frame F;
    F.lds = (LAS unsigned char*)lds;
    F.wave = __builtin_amdgcn_readfirstlane((int)threadIdx.x >> 6);
    F.G = gridDim.x; { const int bx = blockIdx.x; F.vcu = (F.G % 8 == 0) ? (bx % 8) * (F.G / 8) + bx / 8 : bx; }
    F.ws = args.ws;
    volatile LAS unsigned* MISC = (volatile LAS unsigned*)(F.lds + MISC_OFF);
    for (int u = threadIdx.x; u < (LDS_BYTES - LDSCTL_OFF) / 4; u += NWAVES * 64) ((LAS unsigned*)(F.lds + LDSCTL_OFF))[u] = 0u;
    __syncthreads();
    XcdBarrier bar = xcd_barrier_post((unsigned*)(args.ws + WS_CTL) + CW_BAR, MISC + 8);
#define GRID_BAR() xcd_barrier(bar)

    unsigned char* ws = args.ws;
    bf16_t* XN = (bf16_t*)(ws + WS_XN);
    bf16_t* X16 = (bf16_t*)(ws + WS_X16);
    float* RS = (float*)(ws + WS_RS);
    bf16_t* PROJ = (bf16_t*)(ws + WS_BIG);
    bf16_t* ACT = (bf16_t*)(ws + WS_ACT);
    bf16_t* BR = (bf16_t*)(ws + WS_BR);

    prologue_small(F, AIN(3), AIN(5));
    convert_weights(F, AIN(1), AIN(2), AIN(7), AIN(10), AIN(11), AIN(13));
    init_rows(F, AIN(0), X16, RS);
    GRID_BAR();

    for (int l = 0; l < DEPTH; ++l) {
        { pg8::Gemm g{X16, (const bf16_t*)(ws + WS_WIN), MTOK, NIN, DM}; pg8::StaticOrder S; S.init(MTOK, NIN, F.G, (int)blockIdx.x);
          pg8::EpiProj E{PROJ, (const float*)(ws + WS_ROPE), RS};
          pg8::gemm_phase<pg8::EpiProj, pg8::StaticOrder, true, true>(F.lds, g, S, E); }
        GRID_BAR();
        hgrn_phase<false>(F, l, PROJ);
        __syncthreads();
        dilated_phase(F, PROJ, XN);
        GRID_BAR();
        hgrn_scan(F);
        GRID_BAR();
        hgrn_phase<true>(F, l, PROJ);
        __syncthreads();
        { const float lam_init = (l == 0) ? 0.2f : (l == 1) ? 0.35550906759096934f : (l == 2) ? 0.4707130183435842f : 0.5560582041556406f;
          diffattn_phase<0>(F, PROJ, XN, (const float*)(ws + WS_LAM) + l, 1.f - lam_init, AIN(6) + l * 128); }
        GRID_BAR();
        hgrn_combine(F, PROJ, AIN(4) + l * 64, XN);
        GRID_BAR();
        { pg8::Gemm g{XN, (const bf16_t*)(ws + WS_WOUT), MTOK, DM, DM}; pg8::StaticOrder S; S.init(MTOK, DM, F.G, (int)blockIdx.x);
          pg8::EpiBf16P E{BR, DM};
          pg8::gemm_phase<pg8::EpiBf16P, pg8::StaticOrder, true, true>(F.lds, g, S, E); }
        GRID_BAR();
        post_rows(F, BR, X16, RS, nullptr, AIN(12) + l * DM);
        GRID_BAR();
        { pg8::Gemm g{X16, (const bf16_t*)(ws + WS_WUP), MTOK, NUP, DM}; pg8::StaticOrder S; S.init(MTOK, NUP, F.G, (int)blockIdx.x);
          pg8::EpiConv E{ACT, (bf16_t*)(ws + WS_HALO), AIN(8) + (size_t)l * 3 * NUP, AIN(9) + (size_t)l * NUP, RS};
          pg8::gemm_phase<pg8::EpiConv, pg8::StaticOrder, true, true>(F.lds, g, S, E); }
        GRID_BAR();
        conv_fixup(F, (const bf16_t*)(ws + WS_HALO), ACT, AIN(8) + (size_t)l * 3 * NUP, AIN(9) + (size_t)l * NUP);
        GRID_BAR();
        { pg8::Gemm g{ACT, (const bf16_t*)(ws + WS_WDN), MTOK, DM, DFF}; pg8::StaticOrder S; S.init(MTOK, DM, F.G, (int)blockIdx.x);
          pg8::EpiBf16P E{BR, DM};
          pg8::gemm_phase<pg8::EpiBf16P, pg8::StaticOrder, true, true>(F.lds, g, S, E); }
        GRID_BAR();
        post_rows(F, BR, X16, RS, (l + 1 < DEPTH) ? nullptr : kargs()->out, AIN(14) + l * DM);
        if (l + 1 < DEPTH) {
            __syncthreads();
            convert_weights(F, AIN(1) + (size_t)(l + 1) * DM * NIN, AIN(2) + (size_t)(l + 1) * DM * DM, AIN(7) + (size_t)(l + 1) * DM * NUP, AIN(10) + (size_t)(l + 1) * DFF * DM, AIN(11) + (l + 1) * DM, AIN(13) + (l + 1) * DM);
            GRID_BAR();
        }
    }
}

extern "C" void kernel_launch(void* const* d_in, const int* in_sizes, int n_in, void* d_out, int out_size, void* d_ws, size_t ws_size, hipStream_t stream) {
    static int grid = 0;
    if (grid == 0) {
        if (n_in != 15 || in_sizes[0] != MTOK * DM || out_size != MTOK * DM || ws_size < WS_END) {
            fprintf(stderr, "kernel_launch: unexpected shapes (n_in %d, in0 %d, out %d, ws %zu); nothing launched\n", n_in, n_in > 0 ? in_sizes[0] : -1, out_size, ws_size); grid = -1; return; }
        int dev = 0, cus = 0;
        if (hipGetDevice(&dev) != hipSuccess || hipDeviceGetAttribute(&cus, hipDeviceAttributeMultiprocessorCount, dev) != hipSuccess) { grid = -1; return; }
        if (hipFuncSetAttribute((const void*)fwd_kernel, hipFuncAttributeMaxDynamicSharedMemorySize, LDS_BYTES) != hipSuccess) { grid = -1; return; }
        int per_cu = 0;
        if (hipOccupancyMaxActiveBlocksPerMultiprocessor(&per_cu, (const void*)fwd_kernel, NWAVES * 64, LDS_BYTES) != hipSuccess || per_cu < 1)
            fprintf(stderr, "kernel_launch: occupancy query reports %d workgroups per CU\n", per_cu);
        (void)hipGetLastError();
        grid = cus;
    }
    if (grid < 0) return;
    if (hipMemsetAsync((char*)d_ws + WS_CTL, 0, CTL_ZERO_BYTES, stream) != hipSuccess) return;
    Args a{};
    for (int i = 0; i < 15; ++i) a.in[i] = (const float*)d_in[i];
    a.out = (float*)d_out; a.ws = (unsigned char*)d_ws;
    hipLaunchKernelGGL(fwd_kernel, dim3(grid), dim3(NWAVES * 64), LDS_BYTES, stream, a);
}
```

```cpp
#include <hip/hip_runtime.h>
#include <hip/hip_bf16.h>
#include <cstdio>
#include <cstdint>
namespace pg8 {
#define PG8_LAS __attribute__((address_space(3)))
typedef unsigned short bf16_t;
typedef short bf16x8 __attribute__((ext_vector_type(8)));
typedef float f32x4 __attribute__((ext_vector_type(4)));
typedef unsigned u32x4 __attribute__((ext_vector_type(4)));
constexpr int BM = 256, BK = 64, HALF = 128, HTB = HALF * BK * 2  , STAGE_BYTES = 8 * HTB, NXCD = 8, WGM = 8;

__host__ __device__ __forceinline__ int lds_byte(int r, int c) { const int st = (r >> 4) * 2 + (c >> 5), rr = r & 15, cc = c & 31, ob = rr * 64 + cc * 2; return st * 1024 + (ob ^ (((ob >> 9) & 1) << 5)); }
__host__ __device__ __forceinline__ void stage_rc(int b, int& R, int& C) { const int st = b / 1024, sb = b % 1024, swz = sb ^ (((sb >> 9) & 1) << 5); R = (st >> 1) * 16 + swz / 64; C = (st & 1) * 32 + (swz % 64) / 2; }
__host__ __device__ __forceinline__ int perm32(int rho) { const int n = rho >> 4, i = rho & 15; return 8 * (i >> 2) + 4 * n + (i & 3); }

__device__ __forceinline__ void glds16(const void* gp, unsigned ldsaddr) { unsigned keep_; asm volatile("s_mov_b32 %0, m0\n\ts_mov_b32 m0, %2\n\ts_nop 0\n\tglobal_load_lds_dwordx4 %1, off\n\ts_mov_b32 m0, %0"
    : "=&s"(keep_) : "v"(gp), "s"((unsigned)__builtin_amdgcn_readfirstlane((int)ldsaddr)) : "memory"); }
struct Unit { int pm, pn; };
struct Gemm { const bf16_t* A; const bf16_t* Bt; int M, N, K; };

struct StaticOrder {
    int nM, nN, nwg, G, c;
    __host__ __device__ void init(int M, int N, int G_, int c_) { nM = M / BM; nN = N / BM; nwg = nM * nN; G = G_; c = c_; }
    __host__ __device__ bool next(int i, Unit& u) const {
        const long L = (long)i * G + c; if (L >= nwg) return false;
        int wgid = (int)L; { const int q = nwg / NXCD, r = nwg % NXCD, xcd = wgid % NXCD, off = wgid / NXCD; wgid = (xcd < r ? xcd * (q + 1) : r * (q + 1) + (xcd - r) * q) + off; }
        const int nig = WGM * nN, gid = wgid / nig, fm = gid * WGM, gsz = (nM - fm) < WGM ? (nM - fm) : WGM;
        u.pm = fm + ((wgid % nig) % gsz); u.pn = (wgid % nig) / gsz; return true;
    }
    __device__ __forceinline__ void a_ready(const Unit&) const {}
    __device__ __forceinline__ void done(const Unit&) const {}
};

__device__ __forceinline__ unsigned cvt_pk_bf16(float lo, float hi) { unsigned r; asm volatile("v_cvt_pk_bf16_f32 %0, %1, %2" : "=v"(r) : "v"(lo), "v"(hi)); return r; }
typedef float f32x2 __attribute__((ext_vector_type(2)));
constexpr int P_SEQ = 8192, P_NIN = 3584;
typedef unsigned u32x2v __attribute__((ext_vector_type(2)));
typedef float f32x2e __attribute__((ext_vector_type(2)));
constexpr float P_QSCALE = 0.125f * 1.4426950408889634f;
struct EpiProj {
    static constexpr bool PERM = true, PERMA = false, AFTER_DRAIN = false; static constexpr int PBYTES = 0;
    bf16_t* O; const float* rope; const float* rs;
    __device__ __forceinline__ void operator()(const f32x4 (&acc)[2][2][4][2], const Unit& u, int wr, int wc, int fr, int fq, const PG8_LAS unsigned char*) const {
        const int pn = u.pn;
        const bool isrope = (pn <= 1) || (pn >= 8 && pn <= 11);
        const float sc = (pn == 0 || pn == 8 || pn == 9) ? P_QSCALE : 1.f;
        const int row0 = u.pm * BM + wr * 64 + fr;
        const int col0 = pn * BM + wc * 32 + 8 * fq;
        const bool dorope = isrope && ((wc & 1) == 0);
#pragma unroll
        for (int ai = 0; ai < 2; ++ai)
#pragma unroll
            for (int m = 0; m < 4; ++m) {
                const int row = row0 + ai * HALF + m * 16;
                const float rsc = rs[row] * sc;
                bf16_t* rowp = O + (size_t)row * P_NIN + col0;
                if (dorope) {
                    f32x4 cs = (f32x4){rsc, rsc, rsc, rsc}, sn = (f32x4){0.f, 0.f, 0.f, 0.f};
                    if (fq < 2) { const float* rp = rope + (size_t)(row & (P_SEQ - 1)) * 16 + 4 * fq; cs = *(const f32x4*)rp * rsc; sn = *(const f32x4*)(rp + 8) * rsc; }
#pragma unroll
                    for (int bj = 0; bj < 2; ++bj) {
                        const f32x4 v0 = acc[ai][bj][m][0], v1 = acc[ai][bj][m][1];
                        const f32x4 lo = v0 * cs - v1 * sn, hi = v1 * cs + v0 * sn;
                        const unsigned l0 = cvt_pk_bf16(lo[0], lo[1]), l1 = cvt_pk_bf16(lo[2], lo[3]), h0 = cvt_pk_bf16(hi[0], hi[1]), h1 = cvt_pk_bf16(hi[2], hi[3]);
                        const unsigned s0 = (fq == 0) ? h0 : l0, s1 = (fq == 0) ? h1 : l1;
                        const unsigned r0 = __shfl_xor(s0, 16), r1 = __shfl_xor(s1, 16);
                        u32x4 w;
                        if (fq == 0) { w.x = l0; w.y = l1; w.z = r0; w.w = r1; } else if (fq == 1) { w.x = r0; w.y = r1; w.z = h0; w.w = h1; } else { w.x = l0; w.y = l1; w.z = h0; w.w = h1; }
                        *(u32x4*)(rowp + bj * HALF) = w;
                    }
                } else {
#pragma unroll
                    for (int bj = 0; bj < 2; ++bj) {
                        const f32x4 v0 = acc[ai][bj][m][0] * rsc, v1 = acc[ai][bj][m][1] * rsc;
                        u32x4 w; w.x = cvt_pk_bf16(v0[0], v0[1]); w.y = cvt_pk_bf16(v0[2], v0[3]); w.z = cvt_pk_bf16(v1[0], v1[1]); w.w = cvt_pk_bf16(v1[2], v1[3]);
                        *(u32x4*)(rowp + bj * HALF) = w;
                    }
                }
            }
    }
};
struct EpiBf16P {
    static constexpr bool PERM = true, PERMA = false, AFTER_DRAIN = false; static constexpr int PBYTES = 0;
    bf16_t* O; int ldc;
    __device__ __forceinline__ void operator()(const f32x4 (&acc)[2][2][4][2], const Unit& u, int wr, int wc, int fr, int fq, const PG8_LAS unsigned char*) const {
        const int row0 = u.pm * BM + wr * 64 + fr, col0 = u.pn * BM + wc * 32 + 8 * fq;
#pragma unroll
        for (int ai = 0; ai < 2; ++ai)
#pragma unroll
            for (int m = 0; m < 4; ++m) { bf16_t* rowp = O + (size_t)(row0 + ai * HALF + m * 16) * ldc + col0;
#pragma unroll
                for (int bj = 0; bj < 2; ++bj) { const f32x4 v0 = acc[ai][bj][m][0], v1 = acc[ai][bj][m][1];
                    u32x4 w; w.x = cvt_pk_bf16(v0[0], v0[1]); w.y = cvt_pk_bf16(v0[2], v0[3]); w.z = cvt_pk_bf16(v1[0], v1[1]); w.w = cvt_pk_bf16(v1[2], v1[3]);
                    *(u32x4*)(rowp + bj * HALF) = w; } }
    }
};
struct EpiF32 {
    static constexpr bool PERM = false, PERMA = false, AFTER_DRAIN = false; static constexpr int PBYTES = 0;
    float* O; int ldc;
    __device__ __forceinline__ void operator()(const f32x4 (&acc)[2][2][4][2], const Unit& u, int wr, int wc, int fr, int fq, const PG8_LAS unsigned char*) const {
        const int row0 = u.pm * BM + wr * 64 + fr, col0 = u.pn * BM + wc * 32 + 4 * fq;
#pragma unroll
        for (int ai = 0; ai < 2; ++ai)
#pragma unroll
            for (int m = 0; m < 4; ++m) { float* rowp = O + (size_t)(row0 + ai * HALF + m * 16) * ldc + col0;
#pragma unroll
                for (int bj = 0; bj < 2; ++bj)
#pragma unroll
                    for (int n = 0; n < 2; ++n) *(f32x4*)(rowp + bj * HALF + n * 16) = acc[ai][bj][m][n]; }
    }
};
constexpr int P_DFF = 2816, P_NUP = 5632;
__device__ __forceinline__ float dpp_shr1(float old, float src) { return __builtin_bit_cast(float, __builtin_amdgcn_update_dpp(__builtin_bit_cast(int, old), __builtin_bit_cast(int, src), 0x111, 0xF, 0xF, false)); }
__device__ __forceinline__ float dpp_shl1(float old, float src) { return __builtin_bit_cast(float, __builtin_amdgcn_update_dpp(__builtin_bit_cast(int, old), __builtin_bit_cast(int, src), 0x101, 0xF, 0xF, false)); }
__device__ __forceinline__ float dpp_ror1(float src) { return __builtin_bit_cast(float, __builtin_amdgcn_mov_dpp(__builtin_bit_cast(int, src), 0x121, 0xF, 0xF, true)); }
__device__ __forceinline__ float dpp_shr1z(float src) { return __builtin_bit_cast(float, __builtin_amdgcn_mov_dpp(__builtin_bit_cast(int, src), 0x111, 0xF, 0xF, true)); }
__device__ __forceinline__ float dpp_shl1z(float src) { return __builtin_bit_cast(float, __builtin_amdgcn_mov_dpp(__builtin_bit_cast(int, src), 0x101, 0xF, 0xF, true)); }
__device__ __forceinline__ float dpp_rol1(float src) { return __builtin_bit_cast(float, __builtin_amdgcn_mov_dpp(__builtin_bit_cast(int, src), 0x12F, 0xF, 0xF, true)); }
struct EpiConv {
    static constexpr bool PERM = true, PERMA = true, AFTER_DRAIN = false; static constexpr int PBYTES = 5120;
    bf16_t* act; bf16_t* halo; const float* cw; const float* cb; const float* rs;
    __device__ __forceinline__ void stage(const Unit& u, unsigned pb, int wid, int lane) const {
        if (wid < 5) {
            const int a = 2 * wid + (lane >> 5), tap = a & 3;
            const float* src = (wid == 4) ? rs + u.pm * BM + 4 * lane : (tap == 3 ? cb : cw + tap * P_NUP) + (a >> 2) * P_DFF + u.pn * 128 + 4 * (lane & 31);
            glds16(src, pb + wid * 1024);
        }
    }
    __device__ __forceinline__ void operator()(const f32x4 (&acc)[2][2][4][2], const Unit& u, int wr, int wc, int fr_, int fq_, const PG8_LAS unsigned char* pb) const {
        int fr = fr_, fq = fq_; asm volatile("" : "+v"(fr), "+v"(fq));
        const int cbase = u.pn * 128 + wc * 32 + 8 * fq;
        const PG8_LAS unsigned char* pw = pb + (wc * 32 + 8 * fq) * 4;
        constexpr float L2E = 1.4426950408889634f, LN2 = 0.6931471805599453f;
        const bool lo = (fr == 0), hi = (fr == 15);
#pragma unroll
        for (int ai = 0; ai < 2; ++ai) {
            const int blk = u.pm * 4 + ai * 2 + wr;
            const int rowb = blk * 64 + 4 * fr;
            const f32x4 rsm = *(const PG8_LAS f32x4*)(pb + 4096 + ((ai * 2 + wr) * 64 + 4 * fr) * 4);
            u32x2v pk[2][4], hg[2][2], hv[2][2];
#pragma unroll
            for (int n = 0; n < 2; ++n) {
#pragma unroll
                for (int h = 0; h < 2; ++h) {
#define EPC_W(a) (*(const PG8_LAS f32x2e*)(pw + (a) * 512 + n * 16 + h * 8))
                    const f32x2e g0 = EPC_W(0) * L2E, g1 = EPC_W(1) * L2E, g2 = EPC_W(2) * L2E, gb = EPC_W(3) * L2E, v0 = EPC_W(4) * LN2, v1 = EPC_W(5) * LN2, v2 = EPC_W(6) * LN2, vb = EPC_W(7) * LN2;
#undef EPC_W
                    f32x2e Gs[4], Vs[4];
#pragma unroll
                    for (int m = 0; m < 4; ++m) { Gs[m] = (f32x2e){acc[ai][0][m][n][2 * h], acc[ai][0][m][n][2 * h + 1]} * rsm[m]; Vs[m] = (f32x2e){acc[ai][1][m][n][2 * h], acc[ai][1][m][n][2 * h + 1]} * rsm[m]; }
                    f32x2e Gm1, Gp4, Vm1, Vp4;
#pragma unroll
                    for (int j = 0; j < 2; ++j) { Gm1[j] = dpp_shr1z(Gs[3][j]); Vm1[j] = dpp_shr1z(Vs[3][j]); Gp4[j] = dpp_shl1z(Gs[0][j]); Vp4[j] = dpp_shl1z(Vs[0][j]); }
#pragma unroll
                    for (int m = 0; m < 4; ++m) {
                        const f32x2e Gp = m == 0 ? Gm1 : Gs[m > 0 ? m - 1 : 0], Gn = m == 3 ? Gp4 : Gs[m < 3 ? m + 1 : 3], Vp = m == 0 ? Vm1 : Vs[m > 0 ? m - 1 : 0], Vn = m == 3 ? Vp4 : Vs[m < 3 ? m + 1 : 3];
                        const f32x2e g = __builtin_elementwise_fma(Gp, g0, __builtin_elementwise_fma(Gs[m], g1, __builtin_elementwise_fma(Gn, g2, gb)));
                        const f32x2e v = __builtin_elementwise_fma(Vp, v0, __builtin_elementwise_fma(Vs[m], v1, __builtin_elementwise_fma(Vn, v2, vb)));
                        f32x2e sg;
#pragma unroll
                        for (int j = 0; j < 2; ++j) sg[j] = __builtin_amdgcn_rcpf(1.f + __builtin_amdgcn_exp2f(-g[j]));
                        const f32x2e o = g * sg * v;
                        const unsigned w = cvt_pk_bf16(o[0], o[1]);
                        if (h == 0) pk[n][m].x = w; else pk[n][m].y = w;
                    }
#pragma unroll
                    for (int q = 0; q < 2; ++q) {
                        f32x2e hgv, hvv;
#pragma unroll
                        for (int j = 0; j < 2; ++j) { hgv[j] = hi ? Gs[q + 2][j] : Gs[q][j]; hvv[j] = hi ? Vs[q + 2][j] : Vs[q][j]; }
                        const unsigned wg_ = cvt_pk_bf16(hgv[0], hgv[1]), wv_ = cvt_pk_bf16(hvv[0], hvv[1]);
                        if (h == 0) { hg[n][q].x = wg_; hv[n][q].x = wv_; } else { hg[n][q].y = wg_; hv[n][q].y = wv_; }
                    }
                }
            }
#pragma unroll
            for (int m = 0; m < 4; ++m) {
                const bool edge = (m == 0 && lo) || (m == 3 && hi);
                if (!edge) { u32x4 w; w.x = pk[0][m].x; w.y = pk[0][m].y; w.z = pk[1][m].x; w.w = pk[1][m].y; *(u32x4*)(act + (size_t)(rowb + m) * P_DFF + cbase) = w; }
            }
            if (lo || hi) {
#pragma unroll
                for (int q = 0; q < 2; ++q) { bf16_t* hp = halo + ((size_t)blk * 4 + q + (hi ? 2 : 0)) * P_NUP + cbase;
                    u32x4 wg, wv; wg.x = hg[0][q].x; wg.y = hg[0][q].y; wg.z = hg[1][q].x; wg.w = hg[1][q].y; wv.x = hv[0][q].x; wv.y = hv[0][q].y; wv.z = hv[1][q].x; wv.w = hv[1][q].y;
                    *(u32x4*)hp = wg; *(u32x4*)(hp + P_DFF) = wv; }
            }
        }
    }
};
template <class Epi, class Sched, bool ALIGN_EPI = false, bool SP2 = false>
__device__ __forceinline__ void gemm_phase(PG8_LAS unsigned char* lds, const Gemm g, const Sched& S, const Epi& E) {
    int tid_ = threadIdx.x; asm volatile("" : "+v"(tid_));
    const int tid = tid_, wid = __builtin_amdgcn_readfirstlane(tid >> 6), lane = tid & 63, wr = wid >> 2, wc = wid & 3, fr = lane & 15, fq = lane >> 4;
    const int K = g.K, nt = K / BK;
    unsigned voffA[2], voffB[2];
#pragma unroll
    for (int i = 0; i < 2; ++i) { int R, C; stage_rc(tid * 16 + i * 8192, R, C); const int Rb = Epi::PERM ? ((R & ~31) + perm32(R & 31)) : R;
        const int Ra = Epi::PERMA ? ((R & 64) + 4 * (R & 15) + ((R >> 4) & 3)) : R;
        voffA[i] = (unsigned)(Ra * K + C) * 2u; voffB[i] = (unsigned)(Rb * K + C) * 2u; }
    const size_t kstep = (size_t)(BK * 2);
    const size_t hstep = (size_t)HALF * K * 2;
    const size_t tstep = 2 * hstep;
    const unsigned ldsw = (unsigned)wid * 1024u;
    const int aoff = lds_byte(wr * 64 + fr, fq * 8), boff = lds_byte(wc * 32 + fr, fq * 8);
#define PG8_SA(b, h) (((b) * 2 + (h)) * HTB)
#define PG8_SB(b, h) ((4 + (b) * 2 + (h)) * HTB)
#define PG8_STAGE(bufoff, gbase, voff) do { _Pragma("unroll") for (int _i = 0; _i < 2; ++_i) \
        __builtin_amdgcn_global_load_lds((const unsigned*)((const char*)(gbase) + (voff)[_i]), (PG8_LAS unsigned*)(lds + (bufoff) + ldsw + _i * 8192), 16, 0, 0); } while (0)
#define PG8_LDA(dst, b, h) do { _Pragma("unroll") for (int m = 0; m < 4; ++m) _Pragma("unroll") for (int k = 0; k < 2; ++k) dst[m][k] = *(const PG8_LAS bf16x8*)(lds + PG8_SA(b, h) + aoff + m * 2048 + k * 1024); } while (0)
#define PG8_LDB(dst, b, h) do { _Pragma("unroll") for (int n = 0; n < 2; ++n) _Pragma("unroll") for (int k = 0; k < 2; ++k) dst[n][k] = *(const PG8_LAS bf16x8*)(lds + PG8_SB(b, h) + boff + n * 2048 + k * 1024); } while (0)
#define PG8_MMA(ai, bj, At, Bt) do { __builtin_amdgcn_s_setprio(1); _Pragma("unroll") for (int m = 0; m < 4; ++m) _Pragma("unroll") for (int n = 0; n < 2; ++n) _Pragma("unroll") for (int k = 0; k < 2; ++k) \
        acc[ai][bj][m][n] = __builtin_amdgcn_mfma_f32_16x16x32_bf16(Bt[n][k], At[m][k], acc[ai][bj][m][n], 0, 0, 0); __builtin_amdgcn_s_setprio(0); } while (0)
#define PG8_WAIT_V(n) asm volatile("s_waitcnt vmcnt(" #n ")" ::: "memory")
#define PG8_WAIT_L(n) asm volatile("s_waitcnt lgkmcnt(" #n ")" ::: "memory")
#define PG8_BAR __builtin_amdgcn_s_barrier()
#define PG8_SCHED __builtin_amdgcn_sched_barrier(0)
    Unit cur, nxt; int ui = 0;
    if (!S.next(0, cur)) return;
    f32x4 acc[2][2][4][2];
#pragma unroll
    for (int a = 0; a < 2; ++a)
#pragma unroll
        for (int b = 0; b < 2; ++b)
#pragma unroll
            for (int m = 0; m < 4; ++m)
#pragma unroll
                for (int n = 0; n < 2; ++n) acc[a][b][m][n] = (f32x4){0.f, 0.f, 0.f, 0.f};
    bf16x8 At[4][2], B0[2][2], B1[2][2];
    const char* cA = (const char*)g.A + (size_t)cur.pm * tstep; const char* cB = (const char*)g.Bt + (size_t)cur.pn * tstep;
    S.a_ready(cur);
    if constexpr (SP2) {
        PG8_STAGE(PG8_SB(0, 0), cB, voffB); PG8_STAGE(PG8_SB(0, 1), cB + hstep, voffB); PG8_STAGE(PG8_SA(0, 0), cA, voffA); PG8_STAGE(PG8_SA(0, 1), cA + hstep, voffA);
        if (wr == 1) PG8_BAR;
        PG8_WAIT_V(2); PG8_BAR;
        PG8_STAGE(PG8_SB(1, 0), cB + kstep, voffB); PG8_STAGE(PG8_SA(1, 0), cA + kstep, voffA); PG8_STAGE(PG8_SB(1, 1), cB + hstep + kstep, voffB);
        PG8_WAIT_V(6); PG8_BAR;
    } else {
        PG8_STAGE(PG8_SB(0, 0), cB, voffB); PG8_STAGE(PG8_SA(0, 0), cA, voffA); PG8_STAGE(PG8_SB(0, 1), cB + hstep, voffB); PG8_STAGE(PG8_SA(0, 1), cA + hstep, voffA);
        if (wr == 1) PG8_BAR;
        PG8_WAIT_V(4); PG8_BAR;
        PG8_STAGE(PG8_SB(1, 0), cB + kstep, voffB); PG8_STAGE(PG8_SA(1, 0), cA + kstep, voffA); PG8_STAGE(PG8_SB(1, 1), cB + hstep + kstep, voffB);
        PG8_WAIT_V(6); PG8_BAR;
    }
    for (;;) {
        const bool has_next = S.next(ui + 1, nxt);
        const char* nA = has_next ? (const char*)g.A + (size_t)nxt.pm * tstep : cA; const char* nB = has_next ? (const char*)g.Bt + (size_t)nxt.pn * tstep : cB;
        const unsigned pboff = (unsigned)STAGE_BYTES + (unsigned)(ui & 1) * (unsigned)Epi::PBYTES;
        if constexpr (Epi::PBYTES > 0) E.stage(cur, (unsigned)(uintptr_t)lds + pboff, wid, lane);
        for (int t = 0; t < nt; t += 2) {
            const bool last = (t == nt - 2);
            const char* a1 = cA + (size_t)(t + 1) * kstep;
            const char* a2 = last ? nA : cA + (size_t)(t + 2) * kstep; const char* b2 = last ? nB : cB + (size_t)(t + 2) * kstep;
            const char* a3 = a2 + kstep; const char* b3 = b2 + kstep;
            if (last && has_next) S.a_ready(nxt);
            if constexpr (SP2) {
            PG8_LDB(B0, 0, 0); PG8_LDB(B1, 0, 1); PG8_SCHED; PG8_LDA(At, 0, 0); PG8_STAGE(PG8_SA(1, 1), a1 + hstep, voffA);
            PG8_WAIT_V(8); PG8_WAIT_L(0); PG8_BAR; PG8_MMA(0, 0, At, B0); PG8_MMA(0, 1, At, B1); PG8_BAR; PG8_SCHED;
            PG8_LDA(At, 0, 1); PG8_STAGE(PG8_SB(0, 0), b2, voffB); PG8_STAGE(PG8_SB(0, 1), b2 + hstep, voffB); PG8_STAGE(PG8_SA(0, 0), a2, voffA);
            PG8_WAIT_V(8); PG8_WAIT_L(0); PG8_BAR; PG8_MMA(1, 0, At, B0); PG8_MMA(1, 1, At, B1); PG8_BAR; PG8_SCHED;
            PG8_LDB(B0, 1, 0); PG8_LDB(B1, 1, 1); PG8_SCHED; PG8_LDA(At, 1, 0); PG8_STAGE(PG8_SA(0, 1), a2 + hstep, voffA);
            PG8_WAIT_V(8); PG8_WAIT_L(0); PG8_BAR; PG8_MMA(0, 0, At, B0); PG8_MMA(0, 1, At, B1); PG8_BAR; PG8_SCHED;
            PG8_LDA(At, 1, 1); PG8_STAGE(PG8_SB(1, 0), b3, voffB); PG8_STAGE(PG8_SB(1, 1), b3 + hstep, voffB); PG8_STAGE(PG8_SA(1, 0), a3, voffA);
            PG8_WAIT_V(8); PG8_WAIT_L(0); PG8_BAR; PG8_MMA(1, 0, At, B0); PG8_MMA(1, 1, At, B1); PG8_BAR; PG8_SCHED;
            } else {
            PG8_LDB(B0, 0, 0); PG8_SCHED; PG8_LDA(At, 0, 0); PG8_STAGE(PG8_SA(1, 1), a1 + hstep, voffA);
            PG8_WAIT_L(8); PG8_BAR; PG8_WAIT_L(0); PG8_MMA(0, 0, At, B0); PG8_BAR; PG8_SCHED;
            PG8_LDB(B1, 0, 1); PG8_STAGE(PG8_SB(0, 0), b2, voffB);
            PG8_BAR; PG8_WAIT_L(0); PG8_MMA(0, 1, At, B1); PG8_BAR;
            PG8_LDA(At, 0, 1); PG8_STAGE(PG8_SA(0, 0), a2, voffA);
            PG8_BAR; PG8_WAIT_L(0); PG8_MMA(1, 0, At, B0); PG8_BAR; PG8_SCHED;
            PG8_STAGE(PG8_SB(0, 1), b2 + hstep, voffB);
            PG8_WAIT_V(6); PG8_BAR; PG8_MMA(1, 1, At, B1); PG8_BAR;
            PG8_LDB(B0, 1, 0); PG8_SCHED; PG8_LDA(At, 1, 0); PG8_STAGE(PG8_SA(0, 1), a2 + hstep, voffA);
            PG8_WAIT_L(8); PG8_BAR; PG8_WAIT_L(0); PG8_MMA(0, 0, At, B0); PG8_BAR; PG8_SCHED;
            PG8_LDB(B1, 1, 1); PG8_STAGE(PG8_SB(1, 0), b3, voffB);
            PG8_BAR; PG8_WAIT_L(0); PG8_MMA(0, 1, At, B1); PG8_BAR;
            PG8_LDA(At, 1, 1); PG8_STAGE(PG8_SA(1, 0), a3, voffA);
            PG8_BAR; PG8_WAIT_L(0); PG8_MMA(1, 0, At, B0); PG8_BAR; PG8_SCHED;
            PG8_STAGE(PG8_SB(1, 1), b3 + hstep, voffB);
            PG8_WAIT_V(6); PG8_BAR; PG8_MMA(1, 1, At, B1); PG8_BAR;
            }
        }
        if constexpr (ALIGN_EPI) { if (wr == 0) PG8_BAR; }
        if constexpr (!Epi::AFTER_DRAIN) { E(acc, cur, wr, wc, fr, fq, lds + pboff); S.done(cur); }
        if (!has_next) break;
#pragma unroll
        for (int a = 0; a < 2; ++a)
#pragma unroll
            for (int b = 0; b < 2; ++b)
#pragma unroll
                for (int m = 0; m < 4; ++m)
#pragma unroll
                    for (int n = 0; n < 2; ++n) acc[a][b][m][n] = (f32x4){0.f, 0.f, 0.f, 0.f};
        cur = nxt; cA = nA; cB = nB; ++ui;
        if constexpr (ALIGN_EPI) { if (wr == 1) PG8_BAR; }
    }
    PG8_WAIT_V(0);
    if constexpr (!ALIGN_EPI) { if (wr == 0) PG8_BAR; }
    PG8_BAR;
    if constexpr (Epi::AFTER_DRAIN) { E.fused(acc, cur, wr, wc, fr, fq, lds, wid, lane); S.done(cur); }
#undef PG8_SA
#undef PG8_SB
#undef PG8_STAGE
#undef PG8_LDA
#undef PG8_LDB
#undef PG8_MMA
#undef PG8_WAIT_V
#undef PG8_WAIT_L
#undef PG8_BAR
#undef PG8_SCHED
}
}

constexpr int BATCH = 4, SEQ = 8192, DM = 1024, DEPTH = 4, MTOK = BATCH * SEQ;
constexpr int NIN = 3584, DFF = 2816, NUP = 2 * DFF;
constexpr int COL_QA = 0, COL_KA = 256, COL_VA = 512, COL_QB = 768, COL_FZF = 1024, COL_FZB = 1280, COL_IB = 1536, COL_GB = 1792, COL_QC = 2048, COL_KC = 2560, COL_VC = 3072;
constexpr float EPS = 1e-6f;
constexpr int NWAVES = 8;
constexpr int MHALF = MTOK / 2;

constexpr size_t MiB = 1u << 20;
constexpr size_t WS_CTL = 0, CTL_ZERO_BYTES = 64 * 1024;
constexpr size_t WS_ROPE = 1 * MiB;
constexpr size_t WS_LBS = 1 * MiB + 640 * 1024;
constexpr size_t WS_LAM = WS_LBS + 16 * 1024;
constexpr size_t WS_RS = 1 * MiB + 768 * 1024;
constexpr size_t WS_WIN = 2 * MiB;
constexpr size_t WS_WOUT = 9 * MiB;
constexpr size_t WS_WUP = 11 * MiB;
constexpr size_t WS_WDN = 22 * MiB;
constexpr size_t WS_HD = 27 * MiB + 512 * 1024;
constexpr size_t WS_XN = 28 * MiB;
constexpr size_t WS_BIG = 92 * MiB;
constexpr size_t WS_ACT = WS_BIG;
constexpr size_t WS_HALO = WS_BIG + 176 * MiB;
constexpr size_t WS_BR = 356 * MiB;
constexpr size_t WS_X16 = WS_BR + 64 * MiB;
constexpr size_t WS_HS = WS_BR;
constexpr size_t WS_HO = WS_BR + 32 * MiB;
constexpr size_t WS_END = 484 * MiB;
constexpr int CW_BAR = 1024;

constexpr int RING_BYTES = 131072;
constexpr int LDSCTL_OFF = 146432, MISC_OFF = LDSCTL_OFF + 320;
constexpr int LDS_BYTES = 147456;

#define GAS __attribute__((address_space(1)))
#define LAS __attribute__((address_space(3)))
typedef unsigned short bf16_t;
typedef short bf16x8 __attribute__((ext_vector_type(8)));
typedef short s16x4 __attribute__((ext_vector_type(4)));
typedef float f32x4 __attribute__((ext_vector_type(4)));
typedef float f32x2 __attribute__((ext_vector_type(2)));
typedef float f32x16 __attribute__((ext_vector_type(16)));
typedef unsigned u32x4 __attribute__((ext_vector_type(4)));
typedef unsigned u32x2 __attribute__((ext_vector_type(2)));
typedef GAS unsigned gu32;
#define RLX_AGENT __ATOMIC_RELAXED, __HIP_MEMORY_SCOPE_AGENT
#define LDS_WAIT() asm volatile("s_waitcnt lgkmcnt(0)" ::: "memory")
#define VM_WAIT() asm volatile("s_waitcnt vmcnt(0)" ::: "memory")
#define MFMA32(a, b, c) __builtin_amdgcn_mfma_f32_32x32x16_bf16((a), (b), (c), 0, 0, 0)
__device__ __forceinline__ unsigned f2bf(float f) { unsigned u = __builtin_bit_cast(unsigned, f); return (u + 0x7fffu + ((u >> 16) & 1u)) >> 16; }
__device__ __forceinline__ unsigned pk2(float lo, float hi) { return f2bf(lo) | (f2bf(hi) << 16); }
__device__ __forceinline__ float bf2f(unsigned short b) { return __builtin_bit_cast(float, (unsigned)b << 16); }
typedef __bf16 bf16x2_t __attribute__((ext_vector_type(2)));
__device__ __forceinline__ unsigned cvtpk(float lo, float hi) { f32x2 v = {lo, hi}; bf16x2_t b = __builtin_convertvector(v, bf16x2_t); return __builtin_bit_cast(unsigned, b); }
__device__ __forceinline__ unsigned short f2bf1(float x) { return (unsigned short)(cvtpk(x, 0.f) & 0xffffu); }
__device__ __forceinline__ int crow(int r, int hi) { return (r & 3) + 8 * (r >> 2) + 4 * hi; }
typedef short v4i16_t __attribute__((ext_vector_type(4)));
__device__ __forceinline__ s16x4 vtr(const LAS unsigned char* p) { return __builtin_bit_cast(s16x4, __builtin_amdgcn_ds_read_tr16_b64_v4i16((LAS v4i16_t*)p)); }
__device__ __forceinline__ bf16x8 cat8(s16x4 lo, s16x4 hi) { return (bf16x8){lo[0], lo[1], lo[2], lo[3], hi[0], hi[1], hi[2], hi[3]}; }
__device__ __forceinline__ float wave_sum(float v) {
#pragma unroll
    for (int o = 1; o < 64; o <<= 1) v += __shfl_xor(v, o);
    return v;
}
#define MX3(a, b, c) __builtin_fmaxf(__builtin_fmaxf((a), (b)), (c))
__device__ __forceinline__ float xhalf_max(float m) { auto rr = __builtin_amdgcn_permlane32_swap(__float_as_uint(m), __float_as_uint(m), false, false); return __builtin_fmaxf(__uint_as_float(rr[0]), __uint_as_float(rr[1])); }
__device__ __forceinline__ float xhalf_sum(float m) { auto rr = __builtin_amdgcn_permlane32_swap(__float_as_uint(m), __float_as_uint(m), false, false); return __uint_as_float(rr[0]) + __uint_as_float(rr[1]); }
__device__ __forceinline__ int opaque_tid() { int t = threadIdx.x; asm volatile("" : "+v"(t)); return t; }
#define XB_TMO      128
#define XB_XCNT(j)  (256  + 64 * (j))
#define XB_XSUB(j)  (1280 + 64 * (j))
#define XB_XGEN(j)  (2304 + 64 * (j))
#define XB_TOP      3328
#define XB_TOPGEN   3392
#define XCD_BAR_WORDS 3456
#define XB_SPIN_CAP (1u << 18)

__device__ __forceinline__ unsigned xb_ld(unsigned* p)              { return __hip_atomic_load(p, __ATOMIC_RELAXED, __HIP_MEMORY_SCOPE_AGENT); }
__device__ __forceinline__ unsigned xb_add(unsigned* p, unsigned v) { return __hip_atomic_fetch_add(p, v, __ATOMIC_RELAXED, __HIP_MEMORY_SCOPE_AGENT); }
__device__ __forceinline__ unsigned xb_xcc_id() { return (unsigned)__builtin_amdgcn_s_getreg((3 << 11) | 20) & 0xFu; }
#define XB_SPIN(cond, bar) do { unsigned _sp = 0; while (cond) { __builtin_amdgcn_s_sleep(1); \
    if ((++_sp & 255u) == 0u) { if (xb_ld(&(bar)[XB_TMO])) break; if (_sp > XB_SPIN_CAP) { atomicAdd(&(bar)[XB_TMO], 1u); break; } } } } while (0)

struct XcdBarrier {
    unsigned* bar; unsigned x;
    volatile LAS unsigned* st;
};

__device__ __forceinline__ XcdBarrier xcd_barrier_post(unsigned* bar, volatile LAS unsigned* st) {
    XcdBarrier b; b.bar = bar; b.x = xb_xcc_id(); b.st = st;
    if (threadIdx.x == 0) (void)xb_add(&bar[XB_XCNT(b.x)], 1u);
    return b;
}
__device__ __forceinline__ void xcd_barrier_complete(unsigned* bar, unsigned x, unsigned& nloc, unsigned& nx) {
    const unsigned G = gridDim.x * gridDim.y * gridDim.z;
    unsigned sum, cnt, mine, sp = 0u;
    for (;;) {
        sum = 0u; cnt = 0u; mine = 0u;
#pragma unroll
        for (unsigned j = 0; j < 16; ++j) { const unsigned c = xb_ld(&bar[XB_XCNT(j)]); sum += c; cnt += (c > 0u) ? 1u : 0u; mine = (j == x) ? c : mine; }
        if (sum == G) break;
        __builtin_amdgcn_s_sleep(1);
        if ((++sp & 255u) == 0u) { if (xb_ld(&bar[XB_TMO])) break; if (sp > XB_SPIN_CAP) { atomicAdd(&bar[XB_TMO], 1u); break; } }
    }
    nloc = mine > 0u ? mine : 1u; nx = cnt > 0u ? cnt : 1u;
}

__device__ __forceinline__ void xcd_barrier(const XcdBarrier& b) {
    asm volatile("s_waitcnt vmcnt(0)" ::: "memory");
    __syncthreads();
    if (threadIdx.x == 0) {
        unsigned* bar = b.bar; const unsigned bx = xb_xcc_id();
        __builtin_amdgcn_s_waitcnt(0);
        unsigned nloc = b.st[0], nx = b.st[1];
        if (nloc == 0u) { xcd_barrier_complete(bar, bx, nloc, nx); b.st[0] = nloc; b.st[1] = nx; }
        const unsigned old = xb_add(&bar[XB_XSUB(bx)], 1u);
        const unsigned gen = old / nloc;
        if (old + 1u == (gen + 1u) * nloc) {
            __builtin_amdgcn_fence(__ATOMIC_RELEASE, "agent");
            asm volatile("s_waitcnt vmcnt(0)" ::: "memory");
            const unsigned og = xb_add(&bar[XB_TOP], 1u);
            const unsigned tg = og / nx;
            if (og + 1u == (tg + 1u) * nx) xb_add(&bar[XB_TOPGEN], 1u);
            else XB_SPIN(xb_ld(&bar[XB_TOPGEN]) == tg, bar);
            __builtin_amdgcn_fence(__ATOMIC_ACQUIRE, "agent");
            xb_add(&bar[XB_XGEN(bx)], 1u);
            asm volatile("s_waitcnt vmcnt(0)" ::: "memory");
        } else {
            XB_SPIN(xb_ld(&bar[XB_XGEN(bx)]) == gen, bar);
            __builtin_amdgcn_fence(__ATOMIC_ACQUIRE, "agent");
            asm volatile("s_waitcnt vmcnt(0)" ::: "memory");
        }
    }
    __syncthreads();
}

struct Frame {
    LAS unsigned char* lds;
    int wave;
    int vcu, G;
    unsigned char* ws;
};

__device__ __forceinline__ void prologue_small(Frame& F, const float* lb_logits, const float* diff_lambda) {
    const int L_tid = opaque_tid(), L_lane = L_tid & 63;
    const int gt = F.vcu * (NWAVES * 64) + L_tid, NT = F.G * NWAVES * 64;
    float* rope = (float*)(F.ws + WS_ROPE);
    for (int i = gt; i < SEQ * 8; i += NT) {
        const int pos = i >> 3, j = i & 7;
        const double inv = (j == 0) ? 1.0 : (j == 1) ? 0.19392274474868576 : (j == 2) ? 0.03760603093086393 : (j == 3) ? 0.007292664737217109 : (j == 4) ? 0.001414213562373095
                         : (j == 5) ? 0.0002742481756762073 : (j == 6) ? 5.318295896944988e-05 : 1.031338537721246e-05;
        const double rev = (double)pos * inv * 0.15915494309189535;
        const double fr = rev - __builtin_rint(rev);
        const float f = (float)fr;
        rope[pos * 16 + j] = __builtin_amdgcn_cosf(f);
        rope[pos * 16 + 8 + j] = __builtin_amdgcn_sinf(f);
    }
    float* lbs = (float*)(F.ws + WS_LBS);
    for (int i = gt; i < 2 * 256; i += NT) {
        const int dir = i >> 8, c = i & 255;
        float z[DEPTH], mx = -1e30f;
#pragma unroll
        for (int l = 0; l < DEPTH; ++l) { z[l] = lb_logits[(dir * DEPTH + l) * 256 + c]; mx = fmaxf(mx, z[l]); }
        float s = 0.f;
#pragma unroll
        for (int l = 0; l < DEPTH; ++l) { z[l] = __expf(z[l] - mx); s += z[l]; }
        const float is = 1.f / s; float cum = 0.f;
#pragma unroll
        for (int l = 0; l < DEPTH; ++l) { const float p = z[l] * is; cum += p; lbs[(dir * DEPTH + l) * 256 + c] = cum - z[0] * is; }
    }
    if (gt < DEPTH) {
        const float* lp = diff_lambda + gt * 256;
        float s1 = 0.f, s2 = 0.f;
        for (int d = 0; d < 64; ++d) { s1 += lp[d] * lp[64 + d]; s2 += lp[128 + d] * lp[192 + d]; }
        const float lam_init = 0.8f - 0.6f * expf(-0.3f * (float)gt);
        ((float*)(F.ws + WS_LAM))[gt] = expf(s1) - expf(s2) + lam_init;
    }
}

template <bool GATEVAL, bool ROPEPERM = false>
__device__ __forceinline__ void transpose_item(const float* W, int K, int N, bf16_t* WT, LAS float* scr, int item, int lane, const float* gain) {
    const int nblk = N / 32, kb = item / nblk, nb = item % nblk, k0 = 64 * kb, n0 = 32 * nb;
    { float wv[32], gv[32];
#pragma unroll
      for (int i = 0; i < 32; ++i) { const int kk = 2 * i + (lane >> 5); gv[i] = gain ? gain[k0 + kk] : 1.f; wv[i] = W[(size_t)(k0 + kk) * N + n0 + (lane & 31)]; }
#pragma unroll
      for (int i = 0; i < 32; ++i) { const int kk = 2 * i + (lane >> 5); scr[kk * 33 + (lane & 31)] = wv[i] * gv[i]; } }
    LDS_WAIT(); asm volatile("" ::: "memory");
    const int c = lane & 7;
#pragma unroll
    for (int j = 0; j < 4; ++j) { const int n = (lane >> 3) + 8 * j; const LAS float* s = scr + (8 * c) * 33 + n;
        u32x4 o; o.x = cvtpk(s[0 * 33], s[1 * 33]); o.y = cvtpk(s[2 * 33], s[3 * 33]); o.z = cvtpk(s[4 * 33], s[5 * 33]); o.w = cvtpk(s[6 * 33], s[7 * 33]);
        int orow = n0 + n;
        if (ROPEPERM) { const bool rt = (orow < 2 * 256) || (orow >= 8 * 256 && orow < 12 * 256); const int p = orow & 63; if (rt && p >= 4 && p < 12) orow += (p < 8) ? 4 : -4; }
        if (GATEVAL) { const int isv = orow >= DFF, cc = isv ? orow - DFF : orow; orow = 256 * (cc >> 7) + 128 * isv + (cc & 127); }
        *(GAS u32x4*)(WT + (size_t)orow * K + k0 + 8 * c) = o; }
    LDS_WAIT(); asm volatile("" ::: "memory");
}
__device__ __forceinline__ void convert_weights(Frame& F, const float* w_in, const float* w_out, const float* w_up, const float* w_down, const float* g_in, const float* g_up) {
    const int L_tid = opaque_tid(), L_lane = L_tid & 63;
    LAS float* scr = (LAS float*)(F.lds + F.wave * 16384);
    const int gw = F.vcu * NWAVES + F.wave, NGW = F.G * NWAVES;
    constexpr int I_IN = (DM / 64) * (NIN / 32), I_OUT = (DM / 64) * (DM / 32), I_UP = (DM / 64) * (NUP / 32), I_DN = (DFF / 64) * (DM / 32);
    constexpr int NITEMS = I_IN + I_OUT + I_UP + I_DN;
    for (int it = gw; it < NITEMS; it += NGW) {
        int r = it;
        if (r < I_IN) { transpose_item<false, true>(w_in, DM, NIN, (bf16_t*)(F.ws + WS_WIN), scr, r, L_lane, g_in); continue; } r -= I_IN;
        if (r < I_OUT) { transpose_item<false>(w_out, DM, DM, (bf16_t*)(F.ws + WS_WOUT), scr, r, L_lane, nullptr); continue; } r -= I_OUT;
        if (r < I_UP) { transpose_item<true>(w_up, DM, NUP, (bf16_t*)(F.ws + WS_WUP), scr, r, L_lane, g_up); continue; } r -= I_UP;
        transpose_item<false>(w_down, DFF, DM, (bf16_t*)(F.ws + WS_WDN), scr, r, L_lane, nullptr);
    }
}

__device__ __forceinline__ void unpack8(const u32x4 b, f32x4& lo, f32x4& hi) {
    lo = (f32x4){bf2f((unsigned short)(b.x & 0xffffu)), bf2f((unsigned short)(b.x >> 16)), bf2f((unsigned short)(b.y & 0xffffu)), bf2f((unsigned short)(b.y >> 16))};
    hi = (f32x4){bf2f((unsigned short)(b.z & 0xffffu)), bf2f((unsigned short)(b.z >> 16)), bf2f((unsigned short)(b.w & 0xffffu)), bf2f((unsigned short)(b.w >> 16))};
}
__device__ __forceinline__ void init_rows(Frame& F, const float* x, bf16_t* x16, float* rs) {
    const int L_tid = opaque_tid(), L_lane = L_tid & 63;
    const int gw = F.vcu * NWAVES + F.wave, NGW = F.G * NWAVES;
    for (int m0 = gw; m0 < MTOK; m0 += 4 * NGW) {
        f32x4 v[4][4];
#pragma unroll
        for (int q = 0; q < 4; ++q) { const int m = (m0 + q * NGW < MTOK) ? m0 + q * NGW : m0; const f32x4* xr = (const f32x4*)(x + (size_t)m * DM) + 2 * L_lane;
            v[q][0] = xr[0]; v[q][1] = xr[1]; v[q][2] = xr[128]; v[q][3] = xr[129]; }
#pragma unroll
        for (int q = 0; q < 4; ++q) { const int m = m0 + q * NGW;
            float s = 0.f;
#pragma unroll
            for (int j = 0; j < 4; ++j) s += (v[q][j].x * v[q][j].x + v[q][j].y * v[q][j].y) + (v[q][j].z * v[q][j].z + v[q][j].w * v[q][j].w);
            const float r = 1.f / sqrtf(wave_sum(s) * (1.f / DM) + EPS);
            if (m < MTOK) {
                u32x4* o16 = (u32x4*)(x16 + (size_t)m * DM) + L_lane;
#pragma unroll
                for (int j = 0; j < 2; ++j) { u32x4 w; w.x = cvtpk(v[q][2 * j].x, v[q][2 * j].y); w.y = cvtpk(v[q][2 * j].z, v[q][2 * j].w); w.z = cvtpk(v[q][2 * j + 1].x, v[q][2 * j + 1].y); w.w = cvtpk(v[q][2 * j + 1].z, v[q][2 * j + 1].w); o16[64 * j] = w; }
                if (L_lane == 0) rs[m] = r;
            }
        }
    }
}
__device__ __forceinline__ void post_row_load(const bf16_t* br, const bf16_t* x16, int m, int lane, u32x4 (&b)[2], u32x4 (&xb)[2]) {
    const u32x4* brr = (const u32x4*)(br + (size_t)m * DM) + lane;
    const u32x4* xr = (const u32x4*)(x16 + (size_t)m * DM) + lane;
    b[0] = brr[0]; b[1] = brr[64]; xb[0] = xr[0]; xb[1] = xr[64];
}
__device__ __forceinline__ void post_row_finish(const u32x4 (&b)[2], const u32x4 (&xb)[2], bf16_t* x16, float* rs, float* out32, const float* gpost, int m, int lane) {
    f32x4 v[4], xv[4]; float s = 0.f;
    unpack8(b[0], v[0], v[1]); unpack8(b[1], v[2], v[3]); unpack8(xb[0], xv[0], xv[1]); unpack8(xb[1], xv[2], xv[3]);
#pragma unroll
    for (int j = 0; j < 4; ++j) s += (v[j].x * v[j].x + v[j].y * v[j].y) + (v[j].z * v[j].z + v[j].w * v[j].w);
    const float r = 1.f / sqrtf(wave_sum(s) * (1.f / DM) + EPS);
    float s2 = 0.f;
#pragma unroll
    for (int j = 0; j < 4; ++j) { const f32x4 gp = *(const f32x4*)(gpost + 8 * lane + 512 * (j >> 1) + 4 * (j & 1)); xv[j] = xv[j] + v[j] * r * gp;
        s2 += (xv[j].x * xv[j].x + xv[j].y * xv[j].y) + (xv[j].z * xv[j].z + xv[j].w * xv[j].w); }
    if (out32) {
        f32x4* xo = (f32x4*)(out32 + (size_t)m * DM) + 2 * lane;
#pragma unroll
        for (int j = 0; j < 4; ++j) xo[128 * (j >> 1) + (j & 1)] = xv[j];
    } else {
        const float r2 = 1.f / sqrtf(wave_sum(s2) * (1.f / DM) + EPS);
        u32x4* o16 = (u32x4*)(x16 + (size_t)m * DM) + lane;
#pragma unroll
        for (int j = 0; j < 2; ++j) { u32x4 w; w.x = cvtpk(xv[2 * j].x, xv[2 * j].y); w.y = cvtpk(xv[2 * j].z, xv[2 * j].w); w.z = cvtpk(xv[2 * j + 1].x, xv[2 * j + 1].y); w.w = cvtpk(xv[2 * j + 1].z, xv[2 * j + 1].w); o16[64 * j] = w; }
        if (lane == 0) rs[m] = r2;
    }
}
__device__ __forceinline__ void post_rows(Frame& F, const bf16_t* br, bf16_t* x16, float* rs, float* out32, const float* gpost) {
    const int L_tid = opaque_tid(), L_lane = L_tid & 63;
    const int gw = F.vcu * NWAVES + F.wave, NGW = F.G * NWAVES;
    for (int m = gw; m < MTOK; m += 4 * NGW) {
        u32x4 b[4][2], xx[4][2];
#pragma unroll
        for (int q = 0; q < 4; ++q) if (m + q * NGW < MTOK) post_row_load(br, x16, m + q * NGW, L_lane, b[q], xx[q]);
#pragma unroll
        for (int q = 0; q < 4; ++q) if (m + q * NGW < MTOK) post_row_finish(b[q], xx[q], x16, rs, out32, gpost, m + q * NGW, L_lane);
    }
}

__device__ __forceinline__ f32x4 ld4bf(const bf16_t* p) { const u32x2 u = *(const u32x2*)p; return (f32x4){bf2f((unsigned short)(u.x & 0xffffu)), bf2f((unsigned short)(u.x >> 16)), bf2f((unsigned short)(u.y & 0xffffu)), bf2f((unsigned short)(u.y >> 16))}; }
__device__ __forceinline__ void conv_fixup(Frame& F, const bf16_t* halo, bf16_t* act, const float* cw, const float* cb) {
    const int L_tid = opaque_tid();
    const int gt = F.vcu * (NWAVES * 64) + L_tid, NT = F.G * NWAVES * 64;
    constexpr int CG = DFF / 4, NBLK = MTOK / 64;
    constexpr int NIT = CG * NBLK * 2;
    for (int it0 = gt; it0 < NIT; it0 += 3 * NT) {
        u32x2 h[3][6]; f32x4 wv[3][8]; int rowc[3];
#pragma unroll
        for (int q = 0; q < 3; ++q) {
            const int it = (it0 + q * NT < NIT) ? it0 + q * NT : it0;
            const int cg = it % CG, rb = it / CG, blk = rb >> 1, last = rb & 1, c = cg * 4;
            rowc[q] = (blk * 64 + (last ? 63 : 0)) * DFF + c;
            const bf16_t* hc = halo + ((size_t)blk * 4 + (last ? 3 : 0)) * NUP + c;
            const bf16_t* hp = last ? halo + ((size_t)blk * 4 + 2) * NUP + c : halo + ((size_t)(blk - 1) * 4 + 3) * NUP + c;
            const bf16_t* hn = last ? halo + ((size_t)(blk + 1) * 4 + 0) * NUP + c : halo + ((size_t)blk * 4 + 1) * NUP + c;
            const bool nop = (!last) && ((blk & (SEQ / 64 - 1)) == 0), non = last && ((blk & (SEQ / 64 - 1)) == SEQ / 64 - 1);
            const u32x2 z2 = (u32x2){0u, 0u};
            h[q][0] = nop ? z2 : *(const u32x2*)hp; h[q][1] = nop ? z2 : *(const u32x2*)(hp + DFF); h[q][2] = non ? z2 : *(const u32x2*)hn; h[q][3] = non ? z2 : *(const u32x2*)(hn + DFF);
            h[q][4] = *(const u32x2*)hc; h[q][5] = *(const u32x2*)(hc + DFF);
            wv[q][0] = *(const f32x4*)(cw + c); wv[q][1] = *(const f32x4*)(cw + NUP + c); wv[q][2] = *(const f32x4*)(cw + 2 * NUP + c); wv[q][3] = *(const f32x4*)(cb + c);
            wv[q][4] = *(const f32x4*)(cw + DFF + c); wv[q][5] = *(const f32x4*)(cw + NUP + DFF + c); wv[q][6] = *(const f32x4*)(cw + 2 * NUP + DFF + c); wv[q][7] = *(const f32x4*)(cb + DFF + c);
        }
#pragma unroll
        for (int q = 0; q < 3; ++q) {
#define FX_U(u) ((f32x4){bf2f((unsigned short)((u).x & 0xffffu)), bf2f((unsigned short)((u).x >> 16)), bf2f((unsigned short)((u).y & 0xffffu)), bf2f((unsigned short)((u).y >> 16))})
            const f32x4 Gp = FX_U(h[q][0]), Vp = FX_U(h[q][1]), Gn = FX_U(h[q][2]), Vn = FX_U(h[q][3]), G = FX_U(h[q][4]), V = FX_U(h[q][5]);
#undef FX_U
            const f32x4 g = Gp * wv[q][0] + G * wv[q][1] + Gn * wv[q][2] + wv[q][3];
            const f32x4 v = Vp * wv[q][4] + V * wv[q][5] + Vn * wv[q][6] + wv[q][7];
            u32x2 w; w.x = cvtpk(g[0] / (1.f + __expf(-g[0])) * v[0], g[1] / (1.f + __expf(-g[1])) * v[1]); w.y = cvtpk(g[2] / (1.f + __expf(-g[2])) * v[2], g[3] / (1.f + __expf(-g[3])) * v[3]);
            if (it0 + q * NT < NIT) *(u32x2*)(act + (size_t)rowc[q]) = w;
        }
    }
}

constexpr int C_SLOT = 16384, C_VREG = 4 * C_SLOT, C_WSF = 8 * C_SLOT;
template <int VAR>
__device__ __forceinline__ void diffattn_unit(int bh, int qb, const bf16_t* proj, bf16_t* mixcat, LAS unsigned char* lds, const float* lamp, float outscale, const float* diff_g) {
    const int tid = opaque_tid(), lane = tid & 63, r32 = lane & 31, hi = lane >> 5; const int wid = __builtin_amdgcn_readfirstlane(tid >> 6);
    const int cmap = wid >> 2, wq = wid & 3;
    const int b = bh >> 2, h = bh & 3;
    const size_t rowbase = (size_t)b * SEQ; const int q0 = qb * 128;
    LAS float* wsf = (LAS float*)(lds + C_WSF) + wid * 128;
    bf16x8 qr[4];
    { const bf16_t* Qw = proj + (rowbase + q0 + wq * 32 + r32) * NIN + COL_QC + h * 128 + cmap * 64;
#pragma unroll
      for (int d0 = 0; d0 < 4; ++d0) qr[d0] = *(const bf16x8*)(Qw + d0 * 16 + hi * 8); }
    const bf16_t* kg = proj + (rowbase + 4 * wid + (lane >> 4)) * NIN + COL_KC + h * 128 + (((lane & 15) ^ ((4 * wid + (lane >> 4)) & 15)) * 8);
    const bf16_t* vg = proj + (rowbase + 8 * (wid >> 1) + ((lane >> 2) & 7)) * NIN + COL_VC + h * 128 + (wid & 1) * 64 + (lane >> 5) * 32 + (lane & 3) * 8;
    const int kdst = wid * 1024, vdst = C_VREG + (wid >> 1) * 2048 + (wid & 1) * 1024;
    constexpr int NT = SEQ / 64;
    const unsigned ldsb = (unsigned)(uintptr_t)lds;
#define C_GLDS(gp, ldsaddr) do { unsigned keep_; asm volatile("s_mov_b32 %0, m0\n\ts_mov_b32 m0, %2\n\ts_nop 0\n\tglobal_load_lds_dwordx4 %1, off\n\ts_mov_b32 m0, %0" \
        : "=&s"(keep_) : "v"(gp), "s"((unsigned)__builtin_amdgcn_readfirstlane((int)(ldsaddr))) : "memory"); } while (0)
#define C_DMAK(tile) do { const size_t go_ = (size_t)((tile) & (NT - 1)) * 64 * NIN; const unsigned sl_ = ldsb + ((tile) & 3) * C_SLOT + kdst; C_GLDS(kg + go_, sl_); C_GLDS(kg + go_ + 32 * NIN, sl_ + 8192); } while (0)
#define C_DMAV(tile) do { const size_t go_ = (size_t)((tile) & (NT - 1)) * 64 * NIN; const unsigned sl_ = ldsb + ((tile) & 3) * C_SLOT + vdst; C_GLDS(vg + go_, sl_); C_GLDS(vg + go_ + 32 * NIN, sl_ + 8192); } while (0)
    int kof[4];
#pragma unroll
    for (int d0 = 0; d0 < 4; ++d0) kof[d0] = r32 * 256 + (((8 * cmap + 2 * d0 + hi) ^ (r32 & 15)) * 16);
    const LAS unsigned char* vp0 = lds + C_VREG + ((lane >> 4) & 1) * 32 + (lane & 3) * 8 + (4 * hi + ((lane & 15) >> 2)) * 64;
    f32x16 o[4];
#pragma unroll
    for (int d0 = 0; d0 < 4; ++d0) o[d0] = f32x16{};
    float mrun, lrun = 0.f;
    C_DMAK(0); C_DMAV(0); C_DMAK(1); C_DMAV(1); C_DMAK(2); C_DMAV(2); C_DMAK(3);
    VM_WAIT();
    __syncthreads();
    f32x16 p0 = f32x16{}, p1 = f32x16{};
#pragma unroll
    for (int d0 = 0; d0 < 4; ++d0) {
        const bf16x8 k0 = *(const LAS bf16x8*)(lds + kof[d0]), k1 = *(const LAS bf16x8*)(lds + kof[d0] + 8192);
        p0 = MFMA32(k0, qr[d0], p0); p1 = MFMA32(k1, qr[d0], p1);
    }
    { float a = MX3(p0[0], p0[1], p1[0]), bb = MX3(p0[2], p0[3], p1[1]); a = MX3(a, p1[2], p1[3]);
#pragma unroll
      for (int r = 4; r < 16; r += 4) { a = MX3(a, p0[r], p0[r + 1]); bb = MX3(bb, p0[r + 2], p0[r + 3]); a = MX3(a, p1[r], p1[r + 1]); bb = MX3(bb, p1[r + 2], p1[r + 3]); }
      mrun = xhalf_max(__builtin_fmaxf(a, bb));
#pragma unroll
      for (int r = 0; r < 16; ++r) { p0[r] = __builtin_amdgcn_exp2f(p0[r] - mrun); p1[r] = __builtin_amdgcn_exp2f(p1[r] - mrun); } }
    bf16x8 kfe[4];
#pragma unroll
    for (int i = 0; i < 4; ++i) kfe[i] = *(const LAS bf16x8*)(lds + C_SLOT + kof[i >> 1] + (i & 1) * 8192);
    if ((VAR & 512) && wid >= 4) __builtin_amdgcn_s_sleep(8);
    for (int t = (((VAR & 64) && wid >= 4) || (VAR & 1024)) ? NT : 0; t < NT; ++t) {
        f32x16 n0, n1;
        u32x4 pw[4];
        float sacc = 0.f;
        const LAS unsigned char* kq = lds + ((t + 1) & 3) * C_SLOT;
        const LAS unsigned char* kq2 = lds + ((t + 2) & 3) * C_SLOT;
        const LAS unsigned char* vq = vp0 + (t & 3) * C_SLOT;
        bf16x8 kf[8], vf[8];
#pragma unroll
        for (int i = 0; i < 4; ++i) kf[i] = kfe[i];
#pragma unroll
        for (int i = 4; i < 8; ++i) kf[i] = *(const LAS bf16x8*)(kq + kof[i >> 1] + (i & 1) * 8192);
#define C_VFRAG(i) cat8(vtr(vq + ((i) >> 2) * 4096 + ((i) & 3) * 512), vtr(vq + ((i) >> 2) * 4096 + ((i) & 3) * 512 + 2048))
#define C_GA(i, ACC, FIRST, PP, B) do { \
            vf[i] = C_VFRAG(i); \
            if (!(VAR & 32)) { ACC = FIRST ? MFMA32(kf[i], qr[(i) >> 1], f32x16{}) : MFMA32(kf[i], qr[(i) >> 1], ACC); } else if (FIRST) { ACC = f32x16{}; ACC[0] = __builtin_bit_cast(float, (int)kf[i][0]); } \
            if (!(VAR & 4)) { sacc += PP[B]; sacc += PP[B + 1]; sacc += PP[B + 2]; sacc += PP[B + 3]; asm volatile("" : "+v"(sacc)); \
            pw[(i) >> 1][2 * ((i) & 1)] = cvtpk(PP[B], PP[B + 1]); pw[(i) >> 1][2 * ((i) & 1) + 1] = cvtpk(PP[B + 2], PP[B + 3]); asm volatile("" : "+v"(pw[(i) >> 1])); } \
            else { pw[(i) >> 1][2 * ((i) & 1)] = __builtin_bit_cast(unsigned, PP[B]); pw[(i) >> 1][2 * ((i) & 1) + 1] = __builtin_bit_cast(unsigned, PP[B + 2]); } \
            __builtin_amdgcn_sched_barrier(0); } while (0)
        C_GA(0, n0, true, p0, 0);  C_GA(1, n1, true, p0, 4);  C_GA(2, n0, false, p0, 8); C_GA(3, n1, false, p0, 12);
        C_GA(4, n0, false, p1, 0); C_GA(5, n1, false, p1, 4); C_GA(6, n0, false, p1, 8); C_GA(7, n1, false, p1, 12);
#undef C_GA
        lrun += sacc;
        if (!(VAR & 1)) { C_DMAK(t + 4); C_DMAV(t + 3); }
        float mxa, mxb;
#define C_GB(i) do { \
            o[(i) & 3] = MFMA32(__builtin_bit_cast(bf16x8, pw[(i) >> 2]), vf[(i) & 7], o[(i) & 3]); \
            if ((i) < 8) vf[(i) & 7] = C_VFRAG((i) + 8); \
            if ((i) >= 8 && (i) < 12) kfe[(i) - 8] = *(const LAS bf16x8*)(kq2 + kof[((i) - 8) >> 1] + (((i) - 8) & 1) * 8192); \
            if ((i) < 4) { const int c_ = 4 * (i); \
                if ((i) == 0) { mxa = MX3(n0[0], n0[1], n1[0]); mxb = MX3(n0[2], n0[3], n1[1]); mxa = MX3(mxa, n1[2], n1[3]); } \
                else { mxa = MX3(mxa, n0[c_], n0[c_ + 1]); mxb = MX3(mxb, n0[c_ + 2], n0[c_ + 3]); mxa = MX3(mxa, n1[c_], n1[c_ + 1]); mxb = MX3(mxb, n1[c_ + 2], n1[c_ + 3]); } \
                asm volatile("" : "+v"(mxa), "+v"(mxb)); } \
            __builtin_amdgcn_sched_barrier(0); } while (0)
#define C_EX(e) do { float e0 = (VAR & 2) ? n0[e] : __builtin_amdgcn_exp2f(n0[e] - mnew), e1 = (VAR & 2) ? n1[e] : __builtin_amdgcn_exp2f(n1[e] - mnew); asm volatile("" : "+v"(e0), "+v"(e1)); p0[e] = e0; p1[e] = e1; } while (0)
#define C_GBX(i, ea, eb) do { \
            o[(i) & 3] = MFMA32(__builtin_bit_cast(bf16x8, pw[(i) >> 2]), vf[(i) & 7], o[(i) & 3]); \
            if ((i) < 8) vf[(i) & 7] = C_VFRAG((i) + 8); \
            if ((i) >= 8 && (i) < 12) kfe[(i) - 8] = *(const LAS bf16x8*)(kq2 + kof[((i) - 8) >> 1] + (((i) - 8) & 1) * 8192); \
            C_EX(ea); if ((eb) >= 0) C_EX((eb) < 0 ? 0 : (eb)); \
            __builtin_amdgcn_sched_barrier(0); } while (0)
        C_GB(0); C_GB(1); C_GB(2); C_GB(3);
        const float rm = xhalf_max(__builtin_fmaxf(mxa, mxb));
        const float mnew = __builtin_fmaxf(mrun, rm);
        const float al = __builtin_amdgcn_exp2f(mrun - mnew);
        const bool need = __any(mnew > mrun);
        mrun = mnew; lrun *= al;
        __builtin_amdgcn_sched_barrier(0);
        C_GBX(4, 0, 1); C_GBX(5, 2, 3); C_GBX(6, 4, 5); C_GBX(7, 6, 7);
        C_GBX(8, 8, -1); C_GBX(9, 9, -1); C_GBX(10, 10, -1); C_GBX(11, 11, -1); C_GBX(12, 12, -1); C_GBX(13, 13, -1); C_GBX(14, 14, -1); C_GBX(15, 15, -1);
#undef C_GBX
#undef C_EX
#undef C_GB
#undef C_VFRAG
        if (need) {
            if (hi == 0) wsf[r32] = al;
            LDS_WAIT();
#pragma unroll
            for (int g = 0; g < 4; ++g) { const f32x4 a4 = *(const LAS f32x4*)(wsf + 8 * g + 4 * hi);
#pragma unroll
                for (int d0 = 0; d0 < 4; ++d0)
#pragma unroll
                    for (int j = 0; j < 4; ++j) o[d0][4 * g + j] *= a4[j]; }
        }
        asm volatile("s_waitcnt vmcnt(4)" ::: "memory");
        if (!(VAR & 8)) __syncthreads();
    }
    VM_WAIT();
    __syncthreads();
#undef C_DMAK
#undef C_DMAV
#undef C_GLDS
    { const float lt = xhalf_sum(lrun);
      const float sc = (cmap ? *lamp : 1.f) / lt;
      if (hi == 0) wsf[r32] = sc;
      LDS_WAIT();
      LAS float* xb = (LAS float*)(lds + wq * 16384) + lane;
#pragma unroll
      for (int g = 0; g < 4; ++g) { const f32x4 s4 = *(const LAS f32x4*)(wsf + 8 * g + 4 * hi);
#pragma unroll
          for (int d0 = 0; d0 < 4; ++d0)
#pragma unroll
              for (int j = 0; j < 4; ++j) o[d0][4 * g + j] *= s4[j]; }
      if (cmap == 1) {
#pragma unroll
          for (int d0 = 0; d0 < 4; ++d0)
#pragma unroll
              for (int rr = 0; rr < 16; ++rr) xb[(d0 * 16 + rr) * 64] = o[d0][rr];
      }
      __syncthreads();
      if (cmap == 0) {
          float gd[4];
#pragma unroll
          for (int d0 = 0; d0 < 4; ++d0) gd[d0] = diff_g[32 * d0 + r32] * outscale;
          bf16_t* Ow = mixcat + (rowbase + q0 + wq * 32) * DM + 512 + h * 128 + r32;
#pragma unroll
          for (int rr = 0; rr < 16; ++rr) {
              float v[4], ss = 0.f;
#pragma unroll
              for (int d0 = 0; d0 < 4; ++d0) { v[d0] = o[d0][rr] - xb[(d0 * 16 + rr) * 64]; ss += v[d0] * v[d0]; }
#pragma unroll
              for (int s = 1; s < 32; s <<= 1) ss += __shfl_xor(ss, s);
              const float rs = 1.f / sqrtf(ss * (1.f / 128.f) + EPS);
              const int row = crow(rr, hi);
#pragma unroll
              for (int d0 = 0; d0 < 4; ++d0) Ow[(size_t)row * DM + 32 * d0] = f2bf1(v[d0] * rs * gd[d0]);
          }
      }
      __syncthreads();
    }
}
template <int VAR>
__device__ __forceinline__ void diffattn_phase(Frame& F, const bf16_t* proj, bf16_t* mixcat, const float* lamp, float outscale, const float* diff_g) {
    for (int u = F.vcu; u < BATCH * 4 * (SEQ / 128); u += F.G) diffattn_unit<VAR>(u >> 6, u & 63, proj, mixcat, F.lds, lamp, outscale, diff_g);
}

constexpr int A_OST = 0, A_ML = 65536, A_WV = 69632, A_WVB = 8704;
template <int D, bool FIRST, bool LAST, int VAR = 0>
__device__ __forceinline__ void dilated_task(int b, int h, int P0, int j, const bf16_t* proj, bf16_t* mixcat, LAS unsigned char* lds, LAS unsigned char* wlds) {
    const int lane = opaque_tid() & 63, r32 = lane & 31, hi = lane >> 5;
    constexpr int NB = 16 / D, L = SEQ / D;
    const int rho = j / NB, blk = j % NB;
    const int lb0 = P0 / D + 32 * blk;
    const size_t rowbase = (size_t)b * SEQ;
    LAS float* wsf = (LAS float*)(wlds + 4096);
    LAS float* mst = (LAS float*)(lds + A_ML); LAS float* lst = mst + 512;
    const int plq = (32 * blk + r32) * D + rho;
    const int plo = (32 * blk + 4 * hi) * D + rho;
    LAS unsigned char* ktile = wlds + 4608;
    const int kwr = (lane >> 3) * 128 + (((lane & 7) ^ ((lane >> 3) & 7)) * 16);
    int kfo[4];
#pragma unroll
    for (int d0 = 0; d0 < 4; ++d0) kfo[d0] = r32 * 128 + (((2 * d0 + hi) ^ (r32 & 7)) * 16);
    bf16x8 qr[4];
    { const bf16_t* Qg = proj + (rowbase + ((VAR & 1) ? 0 : P0 + (32 * blk + (lane >> 3)) * D + rho)) * ((VAR & 8) ? 768 : NIN) + COL_QA + h * 64 + (lane & 7) * 8;
      u32x4 qs[4];
#pragma unroll
      for (int j = 0; j < 4; ++j) qs[j] = *(const u32x4*)(Qg + (size_t)((VAR & 1) ? 0 : 8 * j * D) * ((VAR & 8) ? 768 : NIN));
#pragma unroll
      for (int j = 0; j < 4; ++j) *(LAS u32x4*)(ktile + kwr + j * 1024) = qs[j];
      LDS_WAIT();
#pragma unroll
      for (int d0 = 0; d0 < 4; ++d0) qr[d0] = *(const LAS bf16x8*)(ktile + kfo[d0]);
      LDS_WAIT(); }
    const bf16_t* Kb = proj + (rowbase + rho) * NIN + COL_KA + h * 64 + (lane & 7) * 8;
    const bf16_t* Vb = proj + (rowbase + rho) * NIN + COL_VA + h * 64 + (lane & 7) * 8;
    f32x16 o[2]; float mrun, lrun;
    if (FIRST || (VAR & 4)) { o[0] = f32x16{}; o[1] = f32x16{}; mrun = -1e30f; lrun = 0.f; }
    else {
        mrun = mst[plq]; lrun = hi ? 0.f : lst[plq];
#pragma unroll
        for (int d0 = 0; d0 < 2; ++d0)
#pragma unroll
            for (int rr = 0; rr < 16; ++rr) o[d0][rr] = bf2f(*(const LAS bf16_t*)(lds + A_OST + (plo + ((rr & 3) + 8 * (rr >> 2)) * D) * 128 + (32 * d0 + r32) * 2));
    }
    u32x4 kst[3][4], vst[2][4];
    const int vw = ((lane & 7) >> 2) * 2048 + (lane >> 3) * 64 + (lane & 3) * 16;
    const LAS unsigned char* vp0 = wlds + ((lane >> 4) & 1) * 32 + (lane & 3) * 8 + (4 * hi + ((lane & 15) >> 2)) * 64;
#pragma unroll
#define A_LOADK(kb, S) do { _Pragma("unroll") for (int j = 0; j < 4; ++j) { int lk = lb0 - 64 + 32 * (kb) + (lane >> 3) + 8 * j; lk = lk < 0 ? 0 : (lk >= L ? L - 1 : lk); \
            kst[S][j] = *(const u32x4*)(Kb + (size_t)((VAR & 1) ? 0 : lk * D) * ((VAR & 8) ? 768 : NIN)); } } while (0)
    A_LOADK(0, 0); A_LOADK(1, 1); A_LOADK(2, 2);
#define A_LOADV(kb, S) do { _Pragma("unroll") for (int q = 0; q < 4; ++q) { int lk = lb0 - 64 + 32 * (kb) + (lane >> 3) + 8 * q; lk = lk < 0 ? 0 : (lk >= L ? L - 1 : lk); \
          vst[S][q] = *(const u32x4*)(Vb + (size_t)((VAR & 1) ? 0 : lk * D) * ((VAR & 8) ? 768 : NIN)); } } while (0)
    A_LOADV(0, 0); A_LOADV(1, 1);
    __builtin_amdgcn_sched_barrier(0);
    f32x16 p[5];
    float mx = -1e30f;
#pragma unroll
    for (int kb = 0; kb < 5; ++kb) {
        f32x16 acc = f32x16{};
#pragma unroll
        for (int j = 0; j < 4; ++j) *(LAS u32x4*)(ktile + kwr + j * 1024) = kst[kb % 3][j];
        if (kb + 3 < 5) A_LOADK(kb + 3, kb % 3);
        LDS_WAIT();
#pragma unroll
        for (int d0 = 0; d0 < 4; ++d0) { const bf16x8 kf = *(const LAS bf16x8*)(ktile + kfo[d0]); if (!(VAR & 2)) acc = MFMA32(kf, qr[d0], acc); else acc[d0] += __builtin_bit_cast(float, (int)kf[0]) + __builtin_bit_cast(float, (int)qr[d0][0]); }
        LDS_WAIT();
        const int lk0 = lb0 - 64 + 32 * kb;
        const int rel = 64 - 32 * kb + r32;
        int klo = rel - 64, khi = rel + 64;
        klo = klo > -lk0 ? klo : -lk0; khi = khi < L - 1 - lk0 ? khi : L - 1 - lk0;
        const unsigned span = (unsigned)(khi - klo);
        const int t0 = 4 * hi - klo;
        const bool any_ok = khi >= klo;
#pragma unroll
        for (int rr = 0; rr < 16; ++rr) { const int kk = (rr & 3) + 8 * (rr >> 2);
            const bool ok = any_ok && ((unsigned)(kk + t0) <= span);
            acc[rr] = ok ? acc[rr] : -__builtin_inff(); mx = __builtin_fmaxf(mx, acc[rr]); }
        p[kb] = acc;
    }
    const float rm = xhalf_max(mx);
    const float mnew = __builtin_fmaxf(mrun, rm);
    const float al = __builtin_amdgcn_exp2f(mrun - mnew);
    mrun = mnew;
    float ls = 0.f;
    u32x4 pw[5][2];
#pragma unroll
    for (int kb = 0; kb < 5; ++kb) {
#pragma unroll
        for (int rr = 0; rr < 16; ++rr) { p[kb][rr] = __builtin_amdgcn_exp2f(p[kb][rr] - mnew); ls += p[kb][rr]; }
        pw[kb][0] = (u32x4){cvtpk(p[kb][0], p[kb][1]), cvtpk(p[kb][2], p[kb][3]), cvtpk(p[kb][4], p[kb][5]), cvtpk(p[kb][6], p[kb][7])};
        pw[kb][1] = (u32x4){cvtpk(p[kb][8], p[kb][9]), cvtpk(p[kb][10], p[kb][11]), cvtpk(p[kb][12], p[kb][13]), cvtpk(p[kb][14], p[kb][15])};
    }
    lrun = lrun * al + ls;
    if (!FIRST) {
        if (hi == 0) wsf[r32] = al;
        LDS_WAIT();
#pragma unroll
        for (int g = 0; g < 4; ++g) { const f32x4 a4 = *(const LAS f32x4*)(wsf + 8 * g + 4 * hi);
#pragma unroll
            for (int d0 = 0; d0 < 2; ++d0)
#pragma unroll
                for (int q = 0; q < 4; ++q) o[d0][4 * g + q] *= a4[q]; }
    }
#pragma unroll
    for (int kb = 0; kb < 5; ++kb) {
#pragma unroll
        for (int q = 0; q < 4; ++q) *(LAS u32x4*)(wlds + vw + q * 512) = vst[kb & 1][q];
        if (kb + 2 < 5) A_LOADV(kb + 2, kb & 1);
        LDS_WAIT();
#pragma unroll
        for (int d0 = 0; d0 < 2; ++d0) {
            const bf16x8 vf0 = cat8(vtr(vp0 + d0 * 2048), vtr(vp0 + d0 * 2048 + 512));
            const bf16x8 vf1 = cat8(vtr(vp0 + d0 * 2048 + 1024), vtr(vp0 + d0 * 2048 + 1536));
            if (!(VAR & 2)) { o[d0] = MFMA32(__builtin_bit_cast(bf16x8, pw[kb][0]), vf0, o[d0]);
            o[d0] = MFMA32(__builtin_bit_cast(bf16x8, pw[kb][1]), vf1, o[d0]); } else { o[d0][0] += __builtin_bit_cast(float, (int)vf0[0]) + __builtin_bit_cast(float, (int)vf1[1]) + __builtin_bit_cast(float, pw[kb][0].x); }
        }
        LDS_WAIT();
    }
#undef A_LOADV
#undef A_LOADK
    const float lt = xhalf_sum(lrun);
    if (VAR & 4) { if (lt == 12345.f) mst[plq] = o[0][0] + o[1][3]; }
    else if (!LAST) {
        if (hi == 0) { mst[plq] = mrun; lst[plq] = lt; }
#pragma unroll
        for (int d0 = 0; d0 < 2; ++d0)
#pragma unroll
            for (int rr = 0; rr < 16; ++rr) *(LAS bf16_t*)(lds + A_OST + (plo + ((rr & 3) + 8 * (rr >> 2)) * D) * 128 + (32 * d0 + r32) * 2) = f2bf1(o[d0][rr]);
    } else {
        if (hi == 0) wsf[r32] = 1.f / lt;
        LDS_WAIT();
        bf16_t* Ow = mixcat + (rowbase + P0 + plo) * DM + h * 64 + r32;
#pragma unroll
        for (int g = 0; g < 4; ++g) { const f32x4 i4 = *(const LAS f32x4*)(wsf + 8 * g + 4 * hi);
#pragma unroll
            for (int q = 0; q < 4; ++q) { const int row = (q + 8 * g) * D;
#pragma unroll
                for (int d0 = 0; d0 < 2; ++d0) Ow[(size_t)row * DM + 32 * d0] = f2bf1(o[d0][4 * g + q] * i4[q]); } }
        LDS_WAIT();
    }
}
template <int VAR = 0>
__device__ __forceinline__ void dilated_phase(Frame& F, const bf16_t* proj, bf16_t* mixcat) {
    LAS unsigned char* wlds = F.lds + A_WV + F.wave * A_WVB;
    for (int c = F.vcu; c < BATCH * 4 * (SEQ / 512); c += F.G) {
        const int bh = c >> 4, b = bh >> 2, h = bh & 3, P0 = (c & 15) * 512;
        dilated_task<16, true, false, VAR>(b, h, P0, F.wave, proj, mixcat, F.lds, wlds);
        dilated_task<16, true, false, VAR>(b, h, P0, F.wave + 8, proj, mixcat, F.lds, wlds);
        __syncthreads();
        dilated_task<4, false, false, VAR>(b, h, P0, F.wave, proj, mixcat, F.lds, wlds);
        dilated_task<4, false, false, VAR>(b, h, P0, F.wave + 8, proj, mixcat, F.lds, wlds);
        __syncthreads();
        dilated_task<1, false, true, VAR>(b, h, P0, F.wave, proj, mixcat, F.lds, wlds);
        dilated_task<1, false, true, VAR>(b, h, P0, F.wave + 8, proj, mixcat, F.lds, wlds);
        __syncthreads();
    }
}

constexpr int HB_PITCH = 144;
constexpr int HB_QT = 0, HB_KT = 32 * HB_PITCH, HB_VT = 2 * 32 * HB_PITCH, HB_SC = HB_VT + 4096, HB_WAVE = 14336;
template <bool WITH_OUT>
__device__ __forceinline__ void hgrn_task(int task, int layer, const bf16_t* proj, const float* lbs, bf16_t* hs, float* hd, bf16_t* ho, LAS unsigned char* wl) {
    const int lane = opaque_tid() & 63, r32 = lane & 31, hi = lane >> 5;
    const int sc = task & 63, chain = task >> 6, dir = chain & 1, h = (chain >> 1) & 3, b = chain >> 3;
    const size_t rowbase = (size_t)b * SEQ;
    const float lb = lbs[(dir * DEPTH + layer) * 256 + h * 64 + lane];
    const float oml = 1.f - lb;
    const int zcol = (dir ? COL_FZB : COL_FZF) + h * 64 + lane;
    LAS float* scr = (LAS float*)(wl + HB_SC);
    f32x16 S[2][2];
#pragma unroll
    for (int mb = 0; mb < 2; ++mb)
#pragma unroll
        for (int vb = 0; vb < 2; ++vb) {
            if (WITH_OUT) {
                const bf16_t* sp = hs + (size_t)task * 4096 + (32 * mb + 4 * hi) * 64 + 32 * vb + r32;
#pragma unroll
                for (int rr = 0; rr < 16; ++rr) S[mb][vb][rr] = bf2f(sp[((rr & 3) + 8 * (rr >> 2)) * 64]);
            } else S[mb][vb] = f32x16{};
        }
    float atot = 0.f;
    const LAS unsigned char* vpP = wl + HB_VT + ((lane >> 4) & 1) * 32 + (lane & 3) * 8 + (4 * hi + ((lane & 15) >> 2)) * 64;
    const LAS unsigned char* vpN = wl + HB_VT + ((lane >> 4) & 1) * 32 + (lane & 3) * 8 + (8 * hi + ((lane & 15) >> 2)) * 64;
    for (int ck = 0; ck < 4; ++ck) {
        const int tau0 = sc * 128 + ck * 32;
        const long pstep = dir ? -(long)NIN : (long)NIN;
        const bf16_t* row0 = proj + (rowbase + (dir ? (SEQ - 1 - tau0) : tau0)) * NIN;
        { const int sr = lane >> 3, gc = (lane & 7) * 8;
          u32x4 zr[4], qw[4], vr[4];
#pragma unroll
          for (int j = 0; j < 4; ++j) { const bf16_t* rp = row0 + (long)(sr + 8 * j) * pstep + h * 64 + gc;
              zr[j] = *(const u32x4*)(rp + (dir ? COL_FZB : COL_FZF)); vr[j] = *(const u32x4*)(rp + COL_IB); if (WITH_OUT) qw[j] = *(const u32x4*)(rp + COL_QB); }
#pragma unroll
          for (int j = 0; j < 4; ++j) { const int s = sr + 8 * j;
              *(LAS u32x4*)(wl + HB_KT + s * 128 + (lane & 7) * 16) = zr[j];
              if (WITH_OUT) *(LAS u32x4*)(wl + HB_QT + s * 128 + (lane & 7) * 16) = qw[j];
              *(LAS u32x4*)(wl + HB_VT + ((lane & 7) >> 2) * 2048 + s * 64 + (lane & 3) * 16) = vr[j]; } }
        LDS_WAIT();
        float a[32], kk[32];
        { float run = 0.f;
#pragma unroll
          for (int s = 0; s < 32; ++s) {
              const float z = bf2f(*(const LAS bf16_t*)(wl + HB_KT + s * 128 + lane * 2));
              const float e = __expf(-z);
              const float sig = __builtin_amdgcn_rcpf(1.f + e);
              const float f = lb + oml * sig;
              run += __logf(f);
              a[s] = run;
              kk[s] = oml * (1.f - sig);
          } }
        const float alast = a[31], aref = a[15];
        atot += alast;
        scr[lane] = __expf(alast); scr[64 + lane] = __expf(aref);
        const float ela = __expf(alast - aref);
        float e2v[32];
#pragma unroll
        for (int s = 0; s < 32; ++s) { const float e1 = __expf(fminf(fmaxf(a[s] - aref, -80.f), 80.f)); e2v[s] = __builtin_amdgcn_rcpf(e1); if (WITH_OUT) a[s] = e1; }
        bf16x8 kA[2][2];
#pragma unroll
        for (int ks = 0; ks < 2; ++ks) {
            u32x4 x0, x1;
#pragma unroll
            for (int q = 0; q < 4; ++q) {
                const int s0 = 16 * ks + 2 * q, s1 = 16 * ks + 8 + 2 * q;
                x0[q] = cvtpk(kk[s0] * e2v[s0] * ela, kk[s0 + 1] * e2v[s0 + 1] * ela);
                x1[q] = cvtpk(kk[s1] * e2v[s1] * ela, kk[s1 + 1] * e2v[s1 + 1] * ela);
            }
            u32x4 f0, f1;
#pragma unroll
            for (int q = 0; q < 4; ++q) { auto rr = __builtin_amdgcn_permlane32_swap(x0[q], x1[q], false, false); f0[q] = rr[0]; f1[q] = rr[1]; }
            kA[0][ks] = __builtin_bit_cast(bf16x8, f0); kA[1][ks] = __builtin_bit_cast(bf16x8, f1);
        }
        if (WITH_OUT) {
            float qc[32];
#pragma unroll
            for (int s = 0; s < 32; ++s) qc[s] = bf2f(*(const LAS bf16_t*)(wl + HB_QT + s * 128 + lane * 2));
            LDS_WAIT();
#pragma unroll
            for (int s = 0; s < 32; ++s) {
                *(LAS bf16_t*)(wl + HB_QT + s * HB_PITCH + lane * 2) = f2bf1(qc[s] * a[s]);
                *(LAS bf16_t*)(wl + HB_KT + s * HB_PITCH + lane * 2) = f2bf1(kk[s] * e2v[s]);
            }
        }
        LDS_WAIT();
        f32x16 O[2];
        if (WITH_OUT) {
            f32x16 p = f32x16{};
#pragma unroll
            for (int kd = 0; kd < 4; ++kd) {
                const bf16x8 kf = *(const LAS bf16x8*)(wl + HB_KT + r32 * HB_PITCH + kd * 32 + hi * 16);
                const bf16x8 qf = *(const LAS bf16x8*)(wl + HB_QT + r32 * HB_PITCH + kd * 32 + hi * 16);
                p = MFMA32(kf, qf, p);
            }
#pragma unroll
            for (int rr = 0; rr < 16; ++rr) { const int s = (rr & 3) + 8 * (rr >> 2) + 4 * hi; p[rr] = (s <= r32) ? p[rr] : 0.f; }
            const u32x4 pw0 = (u32x4){cvtpk(p[0], p[1]), cvtpk(p[2], p[3]), cvtpk(p[4], p[5]), cvtpk(p[6], p[7])};
            const u32x4 pw1 = (u32x4){cvtpk(p[8], p[9]), cvtpk(p[10], p[11]), cvtpk(p[12], p[13]), cvtpk(p[14], p[15])};
#pragma unroll
            for (int vb = 0; vb < 2; ++vb) {
                const bf16x8 vf0 = cat8(vtr(vpP + vb * 2048), vtr(vpP + vb * 2048 + 512));
                const bf16x8 vf1 = cat8(vtr(vpP + vb * 2048 + 1024), vtr(vpP + vb * 2048 + 1536));
                O[vb] = MFMA32(__builtin_bit_cast(bf16x8, pw0), vf0, f32x16{});
                O[vb] = MFMA32(__builtin_bit_cast(bf16x8, pw1), vf1, O[vb]);
            }
#pragma unroll
            for (int mb = 0; mb < 2; ++mb)
#pragma unroll
                for (int sp = 0; sp < 2; ++sp) {
                    const f32x4 e0 = *(const LAS f32x4*)(scr + 64 + 32 * mb + 16 * sp + 4 * hi), e1 = *(const LAS f32x4*)(scr + 64 + 32 * mb + 16 * sp + 8 + 4 * hi);
                    const u32x2 qa = *(const LAS u32x2*)(wl + HB_QT + r32 * HB_PITCH + (32 * mb + 16 * sp + 4 * hi) * 2);
                    const u32x2 qb = *(const LAS u32x2*)(wl + HB_QT + r32 * HB_PITCH + (32 * mb + 16 * sp + 8 + 4 * hi) * 2);
                    const bf16x8 qf = __builtin_bit_cast(bf16x8, (u32x4){qa.x, qa.y, qb.x, qb.y});
#pragma unroll
                    for (int vb = 0; vb < 2; ++vb) {
                        const f32x16& X = S[mb][vb];
                        const u32x4 sw = (u32x4){cvtpk(X[8 * sp] * e0[0], X[8 * sp + 1] * e0[1]), cvtpk(X[8 * sp + 2] * e0[2], X[8 * sp + 3] * e0[3]),
                                                 cvtpk(X[8 * sp + 4] * e1[0], X[8 * sp + 5] * e1[1]), cvtpk(X[8 * sp + 6] * e1[2], X[8 * sp + 7] * e1[3])};
                        O[vb] = MFMA32(qf, __builtin_bit_cast(bf16x8, sw), O[vb]);
                    }
                }
            bf16_t* op = ho + ((size_t)dir * MTOK + rowbase) * 256 + h * 64 + r32;
#pragma unroll
            for (int vb = 0; vb < 2; ++vb)
#pragma unroll
                for (int rr = 0; rr < 16; ++rr) { const int t = (rr & 3) + 8 * (rr >> 2) + 4 * hi; const int pos = dir ? (SEQ - 1 - (tau0 + t)) : (tau0 + t);
                    op[(size_t)pos * 256 + 32 * vb] = f2bf1(O[vb][rr]); }
        }
#pragma unroll
        for (int mb = 0; mb < 2; ++mb) {
#pragma unroll
            for (int g = 0; g < 4; ++g) { const f32x4 e4 = *(const LAS f32x4*)(scr + 32 * mb + 8 * g + 4 * hi);
#pragma unroll
                for (int vb = 0; vb < 2; ++vb)
#pragma unroll
                    for (int j = 0; j < 4; ++j) S[mb][vb][4 * g + j] *= e4[j]; }
        }
#pragma unroll
        for (int vb = 0; vb < 2; ++vb)
#pragma unroll
            for (int ks = 0; ks < 2; ++ks) {
                const bf16x8 vf = cat8(vtr(vpN + vb * 2048 + ks * 1024), vtr(vpN + vb * 2048 + ks * 1024 + 256));
                S[0][vb] = MFMA32(kA[0][ks], vf, S[0][vb]);
                S[1][vb] = MFMA32(kA[1][ks], vf, S[1][vb]);
            }
        LDS_WAIT();
    }
    if (!WITH_OUT) {
        hd[(size_t)task * 64 + lane] = __expf(atot);
#pragma unroll
        for (int mb = 0; mb < 2; ++mb)
#pragma unroll
            for (int vb = 0; vb < 2; ++vb) { bf16_t* sp = hs + (size_t)task * 4096 + (32 * mb + 4 * hi) * 64 + 32 * vb + r32;
#pragma unroll
                for (int rr = 0; rr < 16; ++rr) sp[((rr & 3) + 8 * (rr >> 2)) * 64] = f2bf1(S[mb][vb][rr]); }
    }
}
template <bool WITH_OUT>
__device__ __forceinline__ void hgrn_phase(Frame& F, int layer, const bf16_t* proj) {
    const int L_tid = opaque_tid(), L_lane = L_tid & 63;
    const int gw = F.vcu * NWAVES + F.wave, NGW = F.G * NWAVES;
    LAS unsigned char* wl = F.lds + F.wave * HB_WAVE;
    for (int task = gw; task < 32 * 64; task += NGW)
        hgrn_task<WITH_OUT>(task, layer, proj, (const float*)(F.ws + WS_LBS), (bf16_t*)(F.ws + WS_HS), (float*)(F.ws + WS_HD), (bf16_t*)(F.ws + WS_HO), wl);
}
__device__ __forceinline__ void hgrn_scan(Frame& F) {
    const int L_tid = opaque_tid(), L_lane = L_tid & 63;
    const int gt = F.vcu * (NWAVES * 64) + L_tid, NT = F.G * NWAVES * 64;
    bf16_t* hs = (bf16_t*)(F.ws + WS_HS); const float* hd = (const float*)(F.ws + WS_HD);
    for (int e = gt; e < 32 * 4096; e += NT) {
        const int chain = e >> 12, dv = e & 4095, d = dv >> 6;
        float s = 0.f;
        bf16_t* p = hs + (size_t)chain * 64 * 4096 + dv; const float* dp = hd + (size_t)chain * 64 * 64 + d;
#pragma unroll
        for (int jb = 0; jb < 64; jb += 32) {
            unsigned short loc[32]; float dec[32];
#pragma unroll
            for (int j = 0; j < 32; ++j) { loc[j] = p[(size_t)(jb + j) * 4096]; dec[j] = dp[(jb + j) * 64]; }
#pragma unroll
            for (int j = 0; j < 32; ++j) { p[(size_t)(jb + j) * 4096] = f2bf1(s); s = dec[j] * s + bf2f(loc[j]); }
        }
    }
}
__device__ __forceinline__ void hgrn_combine(Frame& F, const bf16_t* proj, const float* hg, bf16_t* mixcat) {
    const int L_tid = opaque_tid(), L_lane = L_tid & 63;
    const int gw = F.vcu * NWAVES + F.wave, NGW = F.G * NWAVES;
    const bf16_t* ho = (const bf16_t*)(F.ws + WS_HO);
    const f32x4 g4 = *(const f32x4*)(hg + (L_lane & 15) * 4);
    for (int m0 = gw; m0 < MTOK; m0 += 4 * NGW) {
        u32x2 uf[4], ub[4], gz[4];
#pragma unroll
        for (int q = 0; q < 4; ++q) { const int m = (m0 + q * NGW < MTOK) ? m0 + q * NGW : m0;
            uf[q] = *(const u32x2*)(ho + (size_t)m * 256 + L_lane * 4); ub[q] = *(const u32x2*)(ho + ((size_t)MTOK + m) * 256 + L_lane * 4); gz[q] = *(const u32x2*)(proj + (size_t)m * NIN + COL_GB + L_lane * 4); }
#pragma unroll
        for (int q = 0; q < 4; ++q) { const int m = m0 + q * NGW;
            const f32x4 of = (f32x4){bf2f((unsigned short)(uf[q].x & 0xffffu)), bf2f((unsigned short)(uf[q].x >> 16)), bf2f((unsigned short)(uf[q].y & 0xffffu)), bf2f((unsigned short)(uf[q].y >> 16))};
            const f32x4 ob = (f32x4){bf2f((unsigned short)(ub[q].x & 0xffffu)), bf2f((unsigned short)(ub[q].x >> 16)), bf2f((unsigned short)(ub[q].y & 0xffffu)), bf2f((unsigned short)(ub[q].y >> 16))};
            const f32x4 v = of + ob;
            float ss = (v.x * v.x + v.y * v.y) + (v.z * v.z + v.w * v.w);
            ss += __shfl_xor(ss, 1); ss += __shfl_xor(ss, 2); ss += __shfl_xor(ss, 4); ss += __shfl_xor(ss, 8);
            const float r = 1.f / sqrtf(ss * (1.f / 64.f) + EPS);
            const float z0 = bf2f((unsigned short)(gz[q].x & 0xffffu)), z1 = bf2f((unsigned short)(gz[q].x >> 16)), z2 = bf2f((unsigned short)(gz[q].y & 0xffffu)), z3 = bf2f((unsigned short)(gz[q].y >> 16));
            const float s0 = z0 / (1.f + __expf(-z0)), s1 = z1 / (1.f + __expf(-z1)), s2 = z2 / (1.f + __expf(-z2)), s3 = z3 / (1.f + __expf(-z3));
            u32x2 w; w.x = cvtpk(v.x * r * g4.x * s0, v.y * r * g4.y * s1); w.y = cvtpk(v.z * r * g4.z * s2, v.w * r * g4.w * s3);
            if (m < MTOK) *(u32x2*)(mixcat + (size_t)m * DM + 256 + L_lane * 4) = w; }
    }
}

struct Args { const float* in[15]; float* out; unsigned char* ws; };
typedef __attribute__((address_space(4))) const Args CArgs;
__device__ __forceinline__ CArgs* kargs() { auto p = __builtin_amdgcn_kernarg_segment_ptr(); asm volatile("" : "+s"(p)); return (CArgs*)p; }
#define AIN(i) (kargs()->in[(i)])
__global__ void __launch_bounds__(NWAVES * 64, 2) fwd_kernel(Args args) {
    extern __shared__ __attribute__((aligned(16))) unsigned char lds[];
    Frame F;
    F.lds = (LAS unsigned char*)lds;
    F.wave = __builtin_amdgcn_readfirstlane((int)threadIdx.x >> 6);
    F.G = gridDim.x; { const int bx = blockIdx.x; F.vcu = (F.G % 8 == 0) ? (bx % 8) * (F.G / 8) + bx / 8 : bx; }
    F.ws = args.ws;
    volatile LAS unsigned* MISC = (volatile LAS unsigned*)(F.lds + MISC_OFF);
    for (int u = threadIdx.x; u < (LDS_BYTES - LDSCTL_OFF) / 4; u += NWAVES * 64) ((LAS unsigned*)(F.lds + LDSCTL_OFF))[u] = 0u;
    __syncthreads();
    XcdBarrier bar = xcd_barrier_post((unsigned*)(args.ws + WS_CTL) + CW_BAR, MISC + 8);
#define GRID_BAR() xcd_barrier(bar)

    unsigned char* ws = args.ws;
    bf16_t* XN = (bf16_t*)(ws + WS_XN);
    bf16_t* X16 = (bf16_t*)(ws + WS_X16);
    float* RS = (float*)(ws + WS_RS);
    bf16_t* PROJ = (bf16_t*)(ws + WS_BIG);
    bf16_t* ACT = (bf16_t*)(ws + WS_ACT);
    bf16_t* BR = (bf16_t*)(ws + WS_BR);

    prologue_small(F, AIN(3), AIN(5));
    convert_weights(F, AIN(1), AIN(2), AIN(7), AIN(10), AIN(11), AIN(13));
    init_rows(F, AIN(0), X16, RS);
    GRID_BAR();

    for (int l = 0; l < DEPTH; ++l) {
        { pg8::Gemm g{X16, (const bf16_t*)(ws + WS_WIN), MTOK, NIN, DM}; pg8::StaticOrder S; S.init(MTOK, NIN, F.G, (int)blockIdx.x);
          pg8::EpiProj E{PROJ, (const float*)(ws + WS_ROPE), RS};
          pg8::gemm_phase<pg8::EpiProj, pg8::StaticOrder, true, true>(F.lds, g, S, E); }
        GRID_BAR();
        dilated_phase(F, PROJ, XN);
        __syncthreads();
        hgrn_phase<false>(F, l, PROJ);
        GRID_BAR();
        hgrn_scan(F);
        GRID_BAR();
        hgrn_phase<true>(F, l, PROJ);
        __syncthreads();
        { const float lam_init = (l == 0) ? 0.2f : (l == 1) ? 0.35550906759096934f : (l == 2) ? 0.4707130183435842f : 0.5560582041556406f;
          diffattn_phase<0>(F, PROJ, XN, (const float*)(ws + WS_LAM) + l, 1.f - lam_init, AIN(6) + l * 128); }
        GRID_BAR();
        hgrn_combine(F, PROJ, AIN(4) + l * 64, XN);
        GRID_BAR();
        { pg8::Gemm g{XN, (const bf16_t*)(ws + WS_WOUT), MTOK, DM, DM}; pg8::StaticOrder S; S.init(MTOK, DM, F.G, (int)blockIdx.x);
          pg8::EpiBf16P E{BR, DM};
          pg8::gemm_phase<pg8::EpiBf16P, pg8::StaticOrder, true, true>(F.lds, g, S, E); }
        GRID_BAR();
        post_rows(F, BR, X16, RS, nullptr, AIN(12) + l * DM);
        GRID_BAR();
        { pg8::Gemm g{X16, (const bf16_t*)(ws + WS_WUP), MTOK, NUP, DM}; pg8::StaticOrder S; S.init(MTOK, NUP, F.G, (int)blockIdx.x);
          pg8::EpiConv E{ACT, (bf16_t*)(ws + WS_HALO), AIN(8) + (size_t)l * 3 * NUP, AIN(9) + (size_t)l * NUP, RS};
          pg8::gemm_phase<pg8::EpiConv, pg8::StaticOrder, true, true>(F.lds, g, S, E); }
        GRID_BAR();
        conv_fixup(F, (const bf16_t*)(ws + WS_HALO), ACT, AIN(8) + (size_t)l * 3 * NUP, AIN(9) + (size_t)l * NUP);
        GRID_BAR();
        { pg8::Gemm g{ACT, (const bf16_t*)(ws + WS_WDN), MTOK, DM, DFF}; pg8::StaticOrder S; S.init(MTOK, DM, F.G, (int)blockIdx.x);
          pg8::EpiBf16P E{BR, DM};
          pg8::gemm_phase<pg8::EpiBf16P, pg8::StaticOrder, true, true>(F.lds, g, S, E); }
        GRID_BAR();
        post_rows(F, BR, X16, RS, (l + 1 < DEPTH) ? nullptr : kargs()->out, AIN(14) + l * DM);
        if (l + 1 < DEPTH) {
            __syncthreads();
            convert_weights(F, AIN(1) + (size_t)(l + 1) * DM * NIN, AIN(2) + (size_t)(l + 1) * DM * DM, AIN(7) + (size_t)(l + 1) * DM * NUP, AIN(10) + (size_t)(l + 1) * DFF * DM, AIN(11) + (l + 1) * DM, AIN(13) + (l + 1) * DM);
            GRID_BAR();
        }
    }
}

extern "C" void kernel_launch(void* const* d_in, const int* in_sizes, int n_in, void* d_out, int out_size, void* d_ws, size_t ws_size, hipStream_t stream) {
    static int grid = 0;
    if (grid == 0) {
        if (n_in != 15 || in_sizes[0] != MTOK * DM || out_size != MTOK * DM || ws_size < WS_END) {
            fprintf(stderr, "kernel_launch: unexpected shapes (n_in %d, in0 %d, out %d, ws %zu); nothing launched\n", n_in, n_in > 0 ? in_sizes[0] : -1, out_size, ws_size); grid = -1; return; }
        int dev = 0, cus = 0;
        if (hipGetDevice(&dev) != hipSuccess || hipDeviceGetAttribute(&cus, hipDeviceAttributeMultiprocessorCount, dev) != hipSuccess) { grid = -1; return; }
        if (hipFuncSetAttribute((const void*)fwd_kernel, hipFuncAttributeMaxDynamicSharedMemorySize, LDS_BYTES) != hipSuccess) { grid = -1; return; }
        int per_cu = 0;
        if (hipOccupancyMaxActiveBlocksPerMultiprocessor(&per_cu, (const void*)fwd_kernel, NWAVES * 64, LDS_BYTES) != hipSuccess || per_cu < 1)
            fprintf(stderr, "kernel_launch: occupancy query reports %d workgroups per CU\n", per_cu);
        (void)hipGetLastError();
        grid = cus;
    }
    if (grid < 0) return;
    if (hipMemsetAsync((char*)d_ws + WS_CTL, 0, CTL_ZERO_BYTES, stream) != hipSuccess) return;
    Args a{};
    for (int i = 0; i < 15; ++i) a.in[i] = (const float*)d_in[i];
    a.out = (float*)d_out; a.ws = (unsigned char*)d_ws;
    hipLaunchKernelGGL(fwd_kernel, dim3(grid), dim3(NWAVES * 64), LDS_BYTES, stream, a);
}
```

```cpp
#include <hip/hip_runtime.h>
#include <hip/hip_bf16.h>
#include <cstdio>
#include <cstdint>
namespace pg8 {
#define PG8_LAS __attribute__((address_space(3)))
typedef unsigned short bf16_t;
typedef short bf16x8 __attribute__((ext_vector_type(8)));
typedef float f32x4 __attribute__((ext_vector_type(4)));
typedef unsigned u32x4 __attribute__((ext_vector_type(4)));
constexpr int BM = 256, BK = 64, HALF = 128, HTB = HALF * BK * 2  , STAGE_BYTES = 8 * HTB, NXCD = 8, WGM = 8;

__host__ __device__ __forceinline__ int lds_byte(int r, int c) { const int st = (r >> 4) * 2 + (c >> 5), rr = r & 15, cc = c & 31, ob = rr * 64 + cc * 2; return st * 1024 + (ob ^ (((ob >> 9) & 1) << 5)); }
__host__ __device__ __forceinline__ void stage_rc(int b, int& R, int& C) { const int st = b / 1024, sb = b % 1024, swz = sb ^ (((sb >> 9) & 1) << 5); R = (st >> 1) * 16 + swz / 64; C = (st & 1) * 32 + (swz % 64) / 2; }
__host__ __device__ __forceinline__ int perm32(int rho) { const int n = rho >> 4, i = rho & 15; return 8 * (i >> 2) + 4 * n + (i & 3); }

__device__ __forceinline__ void glds16(const void* gp, unsigned ldsaddr) { unsigned keep_; asm volatile("s_mov_b32 %0, m0\n\ts_mov_b32 m0, %2\n\ts_nop 0\n\tglobal_load_lds_dwordx4 %1, off\n\ts_mov_b32 m0, %0"
    : "=&s"(keep_) : "v"(gp), "s"((unsigned)__builtin_amdgcn_readfirstlane((int)ldsaddr)) : "memory"); }
struct Unit { int pm, pn; };
struct Gemm { const bf16_t* A; const bf16_t* Bt; int M, N, K; };

struct StaticOrder {
    int nM, nN, nwg, G, c;
    __host__ __device__ void init(int M, int N, int G_, int c_) { nM = M / BM; nN = N / BM; nwg = nM * nN; G = G_; c = c_; }
    __host__ __device__ bool next(int i, Unit& u) const {
        const long L = (long)i * G + c; if (L >= nwg) return false;
        int wgid = (int)L; { const int q = nwg / NXCD, r = nwg % NXCD, xcd = wgid % NXCD, off = wgid / NXCD; wgid = (xcd < r ? xcd * (q + 1) : r * (q + 1) + (xcd - r) * q) + off; }
        const int nig = WGM * nN, gid = wgid / nig, fm = gid * WGM, gsz = (nM - fm) < WGM ? (nM - fm) : WGM;
        u.pm = fm + ((wgid % nig) % gsz); u.pn = (wgid % nig) / gsz; return true;
    }
    __device__ __forceinline__ void a_ready(const Unit&) const {}
    __device__ __forceinline__ void done(const Unit&) const {}
};

__device__ __forceinline__ unsigned cvt_pk_bf16(float lo, float hi) { unsigned r; asm volatile("v_cvt_pk_bf16_f32 %0, %1, %2" : "=v"(r) : "v"(lo), "v"(hi)); return r; }
typedef float f32x2 __attribute__((ext_vector_type(2)));
constexpr int P_SEQ = 8192, P_NIN = 3584;
typedef unsigned u32x2v __attribute__((ext_vector_type(2)));
typedef float f32x2e __attribute__((ext_vector_type(2)));
constexpr float P_QSCALE = 0.125f * 1.4426950408889634f;
struct EpiProj {
    static constexpr bool PERM = true, PERMA = false, AFTER_DRAIN = false; static constexpr int PBYTES = 0;
    bf16_t* O; const float* rope; const float* rs;
    __device__ __forceinline__ void operator()(const f32x4 (&acc)[2][2][4][2], const Unit& u, int wr, int wc, int fr, int fq, const PG8_LAS unsigned char*) const {
        const int pn = u.pn;
        const bool isrope = (pn <= 1) || (pn >= 8 && pn <= 11);
        const float sc = (pn == 0 || pn == 8 || pn == 9) ? P_QSCALE : 1.f;
        const int row0 = u.pm * BM + wr * 64 + fr;
        const int col0 = pn * BM + wc * 32 + 8 * fq;
        const bool dorope = isrope && ((wc & 1) == 0);
        if (dorope) steps<true>(acc, row0, col0, fq, sc); else steps<false>(acc, row0, col0, fq, sc);
    }
    template <bool ROPE>
    __device__ __forceinline__ void steps(const f32x4 (&acc)[2][2][4][2], int row0, int col0, int fq, float sc) const {
        const float* rpb = rope + 4 * (fq & 1);
        f32x4 r4n = *(const f32x4*)(rs + (size_t)row0 * 4), csn = (f32x4){0.f, 0.f, 0.f, 0.f}, snn = csn;
        if (ROPE) { const float* rp = rpb + (size_t)(row0 & (P_SEQ - 1)) * 16; csn = *(const f32x4*)rp; snn = *(const f32x4*)(rp + 8); }
#pragma unroll
        for (int st = 0; st < 8; ++st) {
            const int ai = st >> 2, m = st & 3;
            const int row = row0 + ai * HALF + m * 16;
            const f32x4 r4_ = r4n, csl = csn, snl = snn;
            if (st + 1 < 8) {
                const int rown = row0 + ((st + 1) >> 2) * HALF + ((st + 1) & 3) * 16;
                r4n = *(const f32x4*)(rs + (size_t)rown * 4);
                if (ROPE) { const float* rp = rpb + (size_t)(rown & (P_SEQ - 1)) * 16; csn = *(const f32x4*)rp; snn = *(const f32x4*)(rp + 8); }
                asm volatile("" ::: "memory");
            }
            const float rsc = __builtin_amdgcn_rsqf(((r4_[0] + r4_[1]) + (r4_[2] + r4_[3])) * (1.f / 1024.f) + 1e-6f) * sc;
            bf16_t* rowp = O + (size_t)row * P_NIN + col0;
            if (ROPE) {
                f32x4 cs = (f32x4){rsc, rsc, rsc, rsc}, sn = (f32x4){0.f, 0.f, 0.f, 0.f};
                if (fq < 2) { cs = csl * rsc; sn = snl * rsc; }
#pragma unroll
                for (int bj = 0; bj < 2; ++bj) {
                    const f32x4 v0 = acc[ai][bj][m][0], v1 = acc[ai][bj][m][1];
                    const f32x4 lo = v0 * cs - v1 * sn, hi = v1 * cs + v0 * sn;
                    const unsigned l0 = cvt_pk_bf16(lo[0], lo[1]), l1 = cvt_pk_bf16(lo[2], lo[3]), h0 = cvt_pk_bf16(hi[0], hi[1]), h1 = cvt_pk_bf16(hi[2], hi[3]);
                    const unsigned s0 = (fq == 0) ? h0 : l0, s1 = (fq == 0) ? h1 : l1;
                    const unsigned r0 = __shfl_xor(s0, 16), r1 = __shfl_xor(s1, 16);
                    u32x4 w;
                    if (fq == 0) { w.x = l0; w.y = l1; w.z = r0; w.w = r1; } else if (fq == 1) { w.x = r0; w.y = r1; w.z = h0; w.w = h1; } else { w.x = l0; w.y = l1; w.z = h0; w.w = h1; }
                    *(u32x4*)(rowp + bj * HALF) = w;
                }
            } else {
#pragma unroll
                for (int bj = 0; bj < 2; ++bj) {
                    const f32x4 v0 = acc[ai][bj][m][0] * rsc, v1 = acc[ai][bj][m][1] * rsc;
                    u32x4 w; w.x = cvt_pk_bf16(v0[0], v0[1]); w.y = cvt_pk_bf16(v0[2], v0[3]); w.z = cvt_pk_bf16(v1[0], v1[1]); w.w = cvt_pk_bf16(v1[2], v1[3]);
                    *(u32x4*)(rowp + bj * HALF) = w;
                }
            }
        }
    }
};
struct EpiBf16P {
    static constexpr bool PERM = true, PERMA = false, AFTER_DRAIN = false; static constexpr int PBYTES = 0;
    bf16_t* O; int ldc;
    __device__ __forceinline__ void operator()(const f32x4 (&acc)[2][2][4][2], const Unit& u, int wr, int wc, int fr, int fq, const PG8_LAS unsigned char*) const {
        const int row0 = u.pm * BM + wr * 64 + fr, col0 = u.pn * BM + wc * 32 + 8 * fq;
#pragma unroll
        for (int ai = 0; ai < 2; ++ai)
#pragma unroll
            for (int m = 0; m < 4; ++m) { bf16_t* rowp = O + (size_t)(row0 + ai * HALF + m * 16) * ldc + col0;
#pragma unroll
                for (int bj = 0; bj < 2; ++bj) { const f32x4 v0 = acc[ai][bj][m][0], v1 = acc[ai][bj][m][1];
                    u32x4 w; w.x = cvt_pk_bf16(v0[0], v0[1]); w.y = cvt_pk_bf16(v0[2], v0[3]); w.z = cvt_pk_bf16(v1[0], v1[1]); w.w = cvt_pk_bf16(v1[2], v1[3]);
                    *(u32x4*)(rowp + bj * HALF) = w; } }
    }
};
struct EpiF32 {
    static constexpr bool PERM = false, PERMA = false, AFTER_DRAIN = false; static constexpr int PBYTES = 0;
    float* O; int ldc;
    __device__ __forceinline__ void operator()(const f32x4 (&acc)[2][2][4][2], const Unit& u, int wr, int wc, int fr, int fq, const PG8_LAS unsigned char*) const {
        const int row0 = u.pm * BM + wr * 64 + fr, col0 = u.pn * BM + wc * 32 + 4 * fq;
#pragma unroll
        for (int ai = 0; ai < 2; ++ai)
#pragma unroll
            for (int m = 0; m < 4; ++m) { float* rowp = O + (size_t)(row0 + ai * HALF + m * 16) * ldc + col0;
#pragma unroll
                for (int bj = 0; bj < 2; ++bj)
#pragma unroll
                    for (int n = 0; n < 2; ++n) *(f32x4*)(rowp + bj * HALF + n * 16) = acc[ai][bj][m][n]; }
    }
};
struct SliceOrder {
    int G, c, i0;
    __device__ void init(int, int, int G_, int c_, int i0_) { G = G_; c = c_; i0 = i0_; }
    __device__ bool next(int i, Unit& u) const {
        const int L = i0 * G + c; if (i != 0 || L >= 512) return false;
        const int wgid = (L & 7) * 64 + (L >> 3), w = wgid & 31;
        u.pm = (wgid >> 5) * 8 + (w & 7); u.pn = w >> 3; return true; }
    __device__ __forceinline__ void a_ready(const Unit&) const {}
    __device__ __forceinline__ void done(const Unit&) const {}
};
struct EpiRmsRes {
    static constexpr bool PERM = true, PERMA = false, AFTER_DRAIN = true; static constexpr int PBYTES = 0;
    bf16_t* x16; float* out32; const float* g; float* rs2; unsigned* xbuf; unsigned* cnt; unsigned want;
    __device__ __forceinline__ void operator()(const f32x4 (&)[2][2][4][2], const Unit&, int, int, int, int, const PG8_LAS unsigned char*) const {}
    __device__ __forceinline__ void fused(f32x4 (&acc)[2][2][4][2], const Unit& u, int wr, int wc, int fr, int fq, PG8_LAS unsigned char* lds, int wid, int lane) const {
        PG8_LAS float* P = (PG8_LAS float*)lds;
        PG8_LAS float* S = (PG8_LAS float*)(lds + 4096);
        PG8_LAS float* P2 = (PG8_LAS float*)(lds + 8192);
        const int t = wid * 64 + lane;
        const int col0 = u.pn * BM + wc * 32 + 8 * fq;
        u32x4 xin[2][4][2];
#pragma unroll
        for (int ai = 0; ai < 2; ++ai)
#pragma unroll
            for (int m = 0; m < 4; ++m)
#pragma unroll
                for (int bj = 0; bj < 2; ++bj) xin[ai][m][bj] = *(const u32x4*)(x16 + (size_t)(u.pm * BM + ai * HALF + wr * 64 + m * 16 + fr) * 1024 + col0 + bj * HALF);
        f32x4 gv[2][2];
#pragma unroll
        for (int bj = 0; bj < 2; ++bj) { gv[bj][0] = *(const f32x4*)(g + col0 + bj * HALF); gv[bj][1] = *(const f32x4*)(g + col0 + bj * HALF + 4); }
#pragma unroll
        for (int ai = 0; ai < 2; ++ai)
#pragma unroll
            for (int m = 0; m < 4; ++m) {
                float q = 0.f;
#pragma unroll
                for (int bj = 0; bj < 2; ++bj)
#pragma unroll
                    for (int n = 0; n < 2; ++n) { const f32x4 x = acc[ai][bj][m][n]; q += (x[0] * x[0] + x[1] * x[1]) + (x[2] * x[2] + x[3] * x[3]); }
                q += __shfl_xor(q, 16); q += __shfl_xor(q, 32);
                if (fq == 0) P[(ai * HALF + wr * 64 + m * 16 + fr) * 4 + wc] = q;
            }
        asm volatile("s_waitcnt lgkmcnt(0)" ::: "memory"); __builtin_amdgcn_s_barrier(); asm volatile("" ::: "memory");
        if (t < BM) {
            const float q = (P[t * 4 + 0] + P[t * 4 + 1]) + (P[t * 4 + 2] + P[t * 4 + 3]);
            __hip_atomic_store(xbuf + ((size_t)(u.pm * BM + t) * 4 + u.pn), __float_as_uint(q), __ATOMIC_RELAXED, __HIP_MEMORY_SCOPE_AGENT);
        }
        asm volatile("s_waitcnt vmcnt(0)" ::: "memory");
        if (lane == 0) __hip_atomic_fetch_add(cnt + 64 * u.pm, 1u, __ATOMIC_RELAXED, __HIP_MEMORY_SCOPE_AGENT);
        if (wid == 0) {
            unsigned sp = 0;
            while ((unsigned)__builtin_amdgcn_readfirstlane((int)__hip_atomic_load(cnt + 64 * u.pm, __ATOMIC_RELAXED, __HIP_MEMORY_SCOPE_AGENT)) < want) { __builtin_amdgcn_s_sleep(2); if (++sp > (1u << 22)) break; }
            __builtin_amdgcn_fence(__ATOMIC_ACQUIRE, "agent");
        }
        asm volatile("s_waitcnt vmcnt(0) lgkmcnt(0)" ::: "memory"); __builtin_amdgcn_s_barrier(); asm volatile("" ::: "memory");
        if (t < BM) {
            const unsigned* slot = xbuf + (size_t)(u.pm * BM + t) * 4; float tot = 0.f;
#pragma unroll
            for (int k = 0; k < 4; ++k) tot += __uint_as_float(__hip_atomic_load(slot + k, __ATOMIC_RELAXED, __HIP_MEMORY_SCOPE_AGENT));
            S[t] = __builtin_amdgcn_rsqf(tot * (1.f / 1024.f) + 1e-6f);
        }
        asm volatile("s_waitcnt lgkmcnt(0)" ::: "memory"); __builtin_amdgcn_s_barrier(); asm volatile("" ::: "memory");
#pragma unroll
        for (int ai = 0; ai < 2; ++ai)
#pragma unroll
            for (int m = 0; m < 4; ++m) {
                const int rt = ai * HALF + wr * 64 + m * 16 + fr; const size_t grow = (size_t)(u.pm * BM + rt);
                const float r = S[rt];
                float s2 = 0.f;
#pragma unroll
                for (int bj = 0; bj < 2; ++bj) {
                    bf16_t* xp = x16 + grow * 1024 + col0 + bj * HALF;
                    const u32x4 xb = xin[ai][m][bj];
                    f32x4 x0 = (f32x4){__uint_as_float(xb.x << 16), __uint_as_float(xb.x & 0xffff0000u), __uint_as_float(xb.y << 16), __uint_as_float(xb.y & 0xffff0000u)};
                    f32x4 x1 = (f32x4){__uint_as_float(xb.z << 16), __uint_as_float(xb.z & 0xffff0000u), __uint_as_float(xb.w << 16), __uint_as_float(xb.w & 0xffff0000u)};
                    x0 = x0 + acc[ai][bj][m][0] * r * gv[bj][0]; x1 = x1 + acc[ai][bj][m][1] * r * gv[bj][1];
                    s2 += ((x0[0] * x0[0] + x0[1] * x0[1]) + (x0[2] * x0[2] + x0[3] * x0[3])) + ((x1[0] * x1[0] + x1[1] * x1[1]) + (x1[2] * x1[2] + x1[3] * x1[3]));
                    if (out32) { float* op = out32 + grow * 1024 + col0 + bj * HALF; *(f32x4*)op = x0; *(f32x4*)(op + 4) = x1; }
                    else { u32x4 w; w.x = cvt_pk_bf16(x0[0], x0[1]); w.y = cvt_pk_bf16(x0[2], x0[3]); w.z = cvt_pk_bf16(x1[0], x1[1]); w.w = cvt_pk_bf16(x1[2], x1[3]); *(u32x4*)xp = w; }
                }
                if (rs2) { s2 += __shfl_xor(s2, 16); s2 += __shfl_xor(s2, 32); if (fq == 0) P2[rt * 4 + wc] = s2; }
            }
        if (rs2) {
            asm volatile("s_waitcnt lgkmcnt(0)" ::: "memory"); __builtin_amdgcn_s_barrier(); asm volatile("" ::: "memory");
            if (t < BM) rs2[((size_t)u.pm * BM + t) * 4 + u.pn] = (P2[t * 4 + 0] + P2[t * 4 + 1]) + (P2[t * 4 + 2] + P2[t * 4 + 3]);
        }
    }
};
constexpr int P_DFF = 2816, P_NUP = 5632;
__device__ __forceinline__ float dpp_shr1(float old, float src) { return __builtin_bit_cast(float, __builtin_amdgcn_update_dpp(__builtin_bit_cast(int, old), __builtin_bit_cast(int, src), 0x111, 0xF, 0xF, false)); }
__device__ __forceinline__ float dpp_shl1(float old, float src) { return __builtin_bit_cast(float, __builtin_amdgcn_update_dpp(__builtin_bit_cast(int, old), __builtin_bit_cast(int, src), 0x101, 0xF, 0xF, false)); }
__device__ __forceinline__ float dpp_ror1(float src) { return __builtin_bit_cast(float, __builtin_amdgcn_mov_dpp(__builtin_bit_cast(int, src), 0x121, 0xF, 0xF, true)); }
__device__ __forceinline__ float dpp_shr1z(float src) { return __builtin_bit_cast(float, __builtin_amdgcn_mov_dpp(__builtin_bit_cast(int, src), 0x111, 0xF, 0xF, true)); }
__device__ __forceinline__ float dpp_shl1z(float src) { return __builtin_bit_cast(float, __builtin_amdgcn_mov_dpp(__builtin_bit_cast(int, src), 0x101, 0xF, 0xF, true)); }
__device__ __forceinline__ float dpp_rol1(float src) { return __builtin_bit_cast(float, __builtin_amdgcn_mov_dpp(__builtin_bit_cast(int, src), 0x12F, 0xF, 0xF, true)); }
struct EpiConv {
    static constexpr bool PERM = true, PERMA = true, AFTER_DRAIN = false; static constexpr int PBYTES = 8192;
    bf16_t* act; bf16_t* halo; const float* cw; const float* cb; const float* rs;
    __device__ __forceinline__ void stage(const Unit& u, unsigned pb, int wid, int lane) const {
        const int a = 2 * (wid & 3) + (lane >> 5), tap = a & 3;
        const float* src = (wid >= 4) ? rs + ((size_t)u.pm * BM + (wid - 4) * 64 + lane) * 4
                                      : (tap == 3 ? cb : cw + tap * P_NUP) + (a >> 2) * P_DFF + u.pn * 128 + 4 * (lane & 31);
        glds16(src, pb + wid * 1024);
    }
    __device__ __forceinline__ void operator()(const f32x4 (&acc)[2][2][4][2], const Unit& u, int wr, int wc, int fr_, int fq_, const PG8_LAS unsigned char* pb) const {
        int fr = fr_, fq = fq_; asm volatile("" : "+v"(fr), "+v"(fq));
        const int cbase = u.pn * 128 + wc * 32 + 8 * fq;
        const PG8_LAS unsigned char* pw = pb + (wc * 32 + 8 * fq) * 4;
        constexpr float L2E = 1.4426950408889634f, LN2 = 0.6931471805599453f;
        const bool lo = (fr == 0), hi = (fr == 15);
#pragma unroll
        for (int ai = 0; ai < 2; ++ai) {
            const int blk = u.pm * 4 + ai * 2 + wr;
            const int rowb = blk * 64 + 4 * fr;
            f32x4 rsm;
#pragma unroll
            for (int q_ = 0; q_ < 4; ++q_) { const f32x4 r4_ = *(const PG8_LAS f32x4*)(pb + 4096 + ((ai * 2 + wr) * 64 + 4 * fr + q_) * 16);
                rsm[q_] = __builtin_amdgcn_rsqf(((r4_[0] + r4_[1]) + (r4_[2] + r4_[3])) * (1.f / 1024.f) + 1e-6f); }
            u32x2v pk[2][4], hg[2][2], hv[2][2];
#pragma unroll
            for (int n = 0; n < 2; ++n) {
#pragma unroll
                for (int h = 0; h < 2; ++h) {
#define EPC_W(a) (*(const PG8_LAS f32x2e*)(pw + (a) * 512 + n * 16 + h * 8))
                    const f32x2e g0 = EPC_W(0) * L2E, g1 = EPC_W(1) * L2E, g2 = EPC_W(2) * L2E, gb = EPC_W(3) * L2E, v0 = EPC_W(4) * LN2, v1 = EPC_W(5) * LN2, v2 = EPC_W(6) * LN2, vb = EPC_W(7) * LN2;
#undef EPC_W
                    f32x2e Gs[4], Vs[4];
#pragma unroll
                    for (int m = 0; m < 4; ++m) { Gs[m] = (f32x2e){acc[ai][0][m][n][2 * h], acc[ai][0][m][n][2 * h + 1]} * rsm[m]; Vs[m] = (f32x2e){acc[ai][1][m][n][2 * h], acc[ai][1][m][n][2 * h + 1]} * rsm[m]; }
                    f32x2e Gm1, Gp4, Vm1, Vp4;
#pragma unroll
                    for (int j = 0; j < 2; ++j) { Gm1[j] = dpp_shr1z(Gs[3][j]); Vm1[j] = dpp_shr1z(Vs[3][j]); Gp4[j] = dpp_shl1z(Gs[0][j]); Vp4[j] = dpp_shl1z(Vs[0][j]); }
#pragma unroll
                    for (int m = 0; m < 4; ++m) {
                        const f32x2e Gp = m == 0 ? Gm1 : Gs[m > 0 ? m - 1 : 0], Gn = m == 3 ? Gp4 : Gs[m < 3 ? m + 1 : 3], Vp = m == 0 ? Vm1 : Vs[m > 0 ? m - 1 : 0], Vn = m == 3 ? Vp4 : Vs[m < 3 ? m + 1 : 3];
                        const f32x2e g = __builtin_elementwise_fma(Gp, g0, __builtin_elementwise_fma(Gs[m], g1, __builtin_elementwise_fma(Gn, g2, gb)));
                        const f32x2e v = __builtin_elementwise_fma(Vp, v0, __builtin_elementwise_fma(Vs[m], v1, __builtin_elementwise_fma(Vn, v2, vb)));
                        f32x2e sg;
#pragma unroll
                        for (int j = 0; j < 2; ++j) sg[j] = __builtin_amdgcn_rcpf(1.f + __builtin_amdgcn_exp2f(-g[j]));
                        const f32x2e o = g * sg * v;
                        const unsigned w = cvt_pk_bf16(o[0], o[1]);
                        if (h == 0) pk[n][m].x = w; else pk[n][m].y = w;
                    }
#pragma unroll
                    for (int q = 0; q < 2; ++q) {
                        f32x2e hgv, hvv;
#pragma unroll
                        for (int j = 0; j < 2; ++j) { hgv[j] = hi ? Gs[q + 2][j] : Gs[q][j]; hvv[j] = hi ? Vs[q + 2][j] : Vs[q][j]; }
                        const unsigned wg_ = cvt_pk_bf16(hgv[0], hgv[1]), wv_ = cvt_pk_bf16(hvv[0], hvv[1]);
                        if (h == 0) { hg[n][q].x = wg_; hv[n][q].x = wv_; } else { hg[n][q].y = wg_; hv[n][q].y = wv_; }
                    }
                }
            }
#pragma unroll
            for (int m = 0; m < 4; ++m) {
                const bool edge = (m == 0 && lo) || (m == 3 && hi);
                if (!edge) { u32x4 w; w.x = pk[0][m].x; w.y = pk[0][m].y; w.z = pk[1][m].x; w.w = pk[1][m].y; *(u32x4*)(act + (size_t)(rowb + m) * P_DFF + cbase) = w; }
            }
            if (lo || hi) {
#pragma unroll
                for (int q = 0; q < 2; ++q) { bf16_t* hp = halo + ((size_t)blk * 4 + q + (hi ? 2 : 0)) * P_NUP + cbase;
                    u32x4 wg, wv; wg.x = hg[0][q].x; wg.y = hg[0][q].y; wg.z = hg[1][q].x; wg.w = hg[1][q].y; wv.x = hv[0][q].x; wv.y = hv[0][q].y; wv.z = hv[1][q].x; wv.w = hv[1][q].y;
                    *(u32x4*)hp = wg; *(u32x4*)(hp + P_DFF) = wv; }
            }
        }
    }
};
template <class Epi, class Sched, bool ALIGN_EPI = false, bool SP2 = false>
__device__ __forceinline__ void gemm_phase(PG8_LAS unsigned char* lds, const Gemm g, const Sched& S, const Epi& E) {
    int tid_ = threadIdx.x; asm volatile("" : "+v"(tid_));
    const int tid = tid_, wid = __builtin_amdgcn_readfirstlane(tid >> 6), lane = tid & 63, wr = wid >> 2, wc = wid & 3, fr = lane & 15, fq = lane >> 4;
    const int K = g.K, nt = K / BK;
    unsigned voffA[2], voffB[2];
#pragma unroll
    for (int i = 0; i < 2; ++i) { int R, C; stage_rc(tid * 16 + i * 8192, R, C); const int Rb = Epi::PERM ? ((R & ~31) + perm32(R & 31)) : R;
        const int Ra = Epi::PERMA ? ((R & 64) + 4 * (R & 15) + ((R >> 4) & 3)) : R;
        voffA[i] = (unsigned)(Ra * K + C) * 2u; voffB[i] = (unsigned)(Rb * K + C) * 2u; }
    const size_t kstep = (size_t)(BK * 2);
    const size_t hstep = (size_t)HALF * K * 2;
    const size_t tstep = 2 * hstep;
    const unsigned ldsw = (unsigned)wid * 1024u;
    const int aoff = lds_byte(wr * 64 + fr, fq * 8), boff = lds_byte(wc * 32 + fr, fq * 8);
#define PG8_SA(b, h) (((b) * 2 + (h)) * HTB)
#define PG8_SB(b, h) ((4 + (b) * 2 + (h)) * HTB)
#define PG8_STAGE(bufoff, gbase, voff) do { _Pragma("unroll") for (int _i = 0; _i < 2; ++_i) \
        __builtin_amdgcn_global_load_lds((const unsigned*)((const char*)(gbase) + (voff)[_i]), (PG8_LAS unsigned*)(lds + (bufoff) + ldsw + _i * 8192), 16, 0, 0); } while (0)
#define PG8_LDA(dst, b, h) do { _Pragma("unroll") for (int m = 0; m < 4; ++m) _Pragma("unroll") for (int k = 0; k < 2; ++k) dst[m][k] = *(const PG8_LAS bf16x8*)(lds + PG8_SA(b, h) + aoff + m * 2048 + k * 1024); } while (0)
#define PG8_LDB(dst, b, h) do { _Pragma("unroll") for (int n = 0; n < 2; ++n) _Pragma("unroll") for (int k = 0; k < 2; ++k) dst[n][k] = *(const PG8_LAS bf16x8*)(lds + PG8_SB(b, h) + boff + n * 2048 + k * 1024); } while (0)
#define PG8_MMA(ai, bj, At, Bt) do { __builtin_amdgcn_s_setprio(1); _Pragma("unroll") for (int m = 0; m < 4; ++m) _Pragma("unroll") for (int n = 0; n < 2; ++n) _Pragma("unroll") for (int k = 0; k < 2; ++k) \
        acc[ai][bj][m][n] = __builtin_amdgcn_mfma_f32_16x16x32_bf16(Bt[n][k], At[m][k], acc[ai][bj][m][n], 0, 0, 0); __builtin_amdgcn_s_setprio(0); } while (0)
#define PG8_WAIT_V(n) asm volatile("s_waitcnt vmcnt(" #n ")" ::: "memory")
#define PG8_WAIT_L(n) asm volatile("s_waitcnt lgkmcnt(" #n ")" ::: "memory")
#define PG8_BAR __builtin_amdgcn_s_barrier()
#define PG8_SCHED __builtin_amdgcn_sched_barrier(0)
    Unit cur, nxt; int ui = 0;
    if (!S.next(0, cur)) return;
    f32x4 acc[2][2][4][2];
#pragma unroll
    for (int a = 0; a < 2; ++a)
#pragma unroll
        for (int b = 0; b < 2; ++b)
#pragma unroll
            for (int m = 0; m < 4; ++m)
#pragma unroll
                for (int n = 0; n < 2; ++n) acc[a][b][m][n] = (f32x4){0.f, 0.f, 0.f, 0.f};
    bf16x8 At[4][2], B0[2][2], B1[2][2];
    const char* cA = (const char*)g.A + (size_t)cur.pm * tstep; const char* cB = (const char*)g.Bt + (size_t)cur.pn * tstep;
    S.a_ready(cur);
    if constexpr (SP2) {
        PG8_STAGE(PG8_SB(0, 0), cB, voffB); PG8_STAGE(PG8_SB(0, 1), cB + hstep, voffB); PG8_STAGE(PG8_SA(0, 0), cA, voffA); PG8_STAGE(PG8_SA(0, 1), cA + hstep, voffA);
        if (wr == 1) PG8_BAR;
        PG8_WAIT_V(2); PG8_BAR;
        PG8_STAGE(PG8_SB(1, 0), cB + kstep, voffB); PG8_STAGE(PG8_SA(1, 0), cA + kstep, voffA); PG8_STAGE(PG8_SB(1, 1), cB + hstep + kstep, voffB);
        PG8_WAIT_V(6); PG8_BAR;
    } else {
        PG8_STAGE(PG8_SB(0, 0), cB, voffB); PG8_STAGE(PG8_SA(0, 0), cA, voffA); PG8_STAGE(PG8_SB(0, 1), cB + hstep, voffB); PG8_STAGE(PG8_SA(0, 1), cA + hstep, voffA);
        if (wr == 1) PG8_BAR;
        PG8_WAIT_V(4); PG8_BAR;
        PG8_STAGE(PG8_SB(1, 0), cB + kstep, voffB); PG8_STAGE(PG8_SA(1, 0), cA + kstep, voffA); PG8_STAGE(PG8_SB(1, 1), cB + hstep + kstep, voffB);
        PG8_WAIT_V(6); PG8_BAR;
    }
    for (;;) {
        const bool has_next = S.next(ui + 1, nxt);
        const char* nA = has_next ? (const char*)g.A + (size_t)nxt.pm * tstep : cA; const char* nB = has_next ? (const char*)g.Bt + (size_t)nxt.pn * tstep : cB;
        const unsigned pboff = (unsigned)STAGE_BYTES + (unsigned)(ui & 1) * (unsigned)Epi::PBYTES;
        if constexpr (Epi::PBYTES > 0) E.stage(cur, (unsigned)(uintptr_t)lds + pboff, wid, lane);
        for (int t = 0; t < nt; t += 2) {
            const bool last = (t == nt - 2);
            const char* a1 = cA + (size_t)(t + 1) * kstep;
            const char* a2 = last ? nA : cA + (size_t)(t + 2) * kstep; const char* b2 = last ? nB : cB + (size_t)(t + 2) * kstep;
            const char* a3 = a2 + kstep; const char* b3 = b2 + kstep;
            if (last && has_next) S.a_ready(nxt);
            if constexpr (SP2) {
            PG8_LDB(B0, 0, 0); PG8_LDB(B1, 0, 1); PG8_SCHED; PG8_LDA(At, 0, 0); PG8_STAGE(PG8_SA(1, 1), a1 + hstep, voffA);
            PG8_WAIT_V(8); PG8_WAIT_L(0); PG8_BAR; PG8_MMA(0, 0, At, B0); PG8_MMA(0, 1, At, B1); PG8_BAR; PG8_SCHED;
            PG8_LDA(At, 0, 1); PG8_STAGE(PG8_SB(0, 0), b2, voffB); PG8_STAGE(PG8_SB(0, 1), b2 + hstep, voffB); PG8_STAGE(PG8_SA(0, 0), a2, voffA);
            PG8_WAIT_V(8); PG8_WAIT_L(0); PG8_BAR; PG8_MMA(1, 0, At, B0); PG8_MMA(1, 1, At, B1); PG8_BAR; PG8_SCHED;
            PG8_LDB(B0, 1, 0); PG8_LDB(B1, 1, 1); PG8_SCHED; PG8_LDA(At, 1, 0); PG8_STAGE(PG8_SA(0, 1), a2 + hstep, voffA);
            PG8_WAIT_V(8); PG8_WAIT_L(0); PG8_BAR; PG8_MMA(0, 0, At, B0); PG8_MMA(0, 1, At, B1); PG8_BAR; PG8_SCHED;
            PG8_LDA(At, 1, 1); PG8_STAGE(PG8_SB(1, 0), b3, voffB); PG8_STAGE(PG8_SB(1, 1), b3 + hstep, voffB); PG8_STAGE(PG8_SA(1, 0), a3, voffA);
            PG8_WAIT_V(8); PG8_WAIT_L(0); PG8_BAR; PG8_MMA(1, 0, At, B0); PG8_MMA(1, 1, At, B1); PG8_BAR; PG8_SCHED;
            } else {
            PG8_LDB(B0, 0, 0); PG8_SCHED; PG8_LDA(At, 0, 0); PG8_STAGE(PG8_SA(1, 1), a1 + hstep, voffA);
            PG8_WAIT_L(8); PG8_BAR; PG8_WAIT_L(0); PG8_MMA(0, 0, At, B0); PG8_BAR; PG8_SCHED;
            PG8_LDB(B1, 0, 1); PG8_STAGE(PG8_SB(0, 0), b2, voffB);
            PG8_BAR; PG8_WAIT_L(0); PG8_MMA(0, 1, At, B1); PG8_BAR;
            PG8_LDA(At, 0, 1); PG8_STAGE(PG8_SA(0, 0), a2, voffA);
            PG8_BAR; PG8_WAIT_L(0); PG8_MMA(1, 0, At, B0); PG8_BAR; PG8_SCHED;
            PG8_STAGE(PG8_SB(0, 1), b2 + hstep, voffB);
            PG8_WAIT_V(6); PG8_BAR; PG8_MMA(1, 1, At, B1); PG8_BAR;
            PG8_LDB(B0, 1, 0); PG8_SCHED; PG8_LDA(At, 1, 0); PG8_STAGE(PG8_SA(0, 1), a2 + hstep, voffA);
            PG8_WAIT_L(8); PG8_BAR; PG8_WAIT_L(0); PG8_MMA(0, 0, At, B0); PG8_BAR; PG8_SCHED;
            PG8_LDB(B1, 1, 1); PG8_STAGE(PG8_SB(1, 0), b3, voffB);
            PG8_BAR; PG8_WAIT_L(0); PG8_MMA(0, 1, At, B1); PG8_BAR;
            PG8_LDA(At, 1, 1); PG8_STAGE(PG8_SA(1, 0), a3, voffA);
            PG8_BAR; PG8_WAIT_L(0); PG8_MMA(1, 0, At, B0); PG8_BAR; PG8_SCHED;
            PG8_STAGE(PG8_SB(1, 1), b3 + hstep, voffB);
            PG8_WAIT_V(6); PG8_BAR; PG8_MMA(1, 1, At, B1); PG8_BAR;
            }
        }
        if constexpr (ALIGN_EPI) { if (wr == 0) PG8_BAR; }
        if constexpr (!Epi::AFTER_DRAIN) { E(acc, cur, wr, wc, fr, fq, lds + pboff); S.done(cur); }
        if (!has_next) break;
#pragma unroll
        for (int a = 0; a < 2; ++a)
#pragma unroll
            for (int b = 0; b < 2; ++b)
#pragma unroll
                for (int m = 0; m < 4; ++m)
#pragma unroll
                    for (int n = 0; n < 2; ++n) acc[a][b][m][n] = (f32x4){0.f, 0.f, 0.f, 0.f};
        cur = nxt; cA = nA; cB = nB; ++ui;
        if constexpr (ALIGN_EPI) { if (wr == 1) PG8_BAR; }
    }
    PG8_WAIT_V(0);
    if constexpr (!ALIGN_EPI) { if (wr == 0) PG8_BAR; }
    PG8_BAR;
    if constexpr (Epi::AFTER_DRAIN) { E.fused(acc, cur, wr, wc, fr, fq, lds, wid, lane); S.done(cur); }
#undef PG8_SA
#undef PG8_SB
#undef PG8_STAGE
#undef PG8_LDA
#undef PG8_LDB
#undef PG8_MMA
#undef PG8_WAIT_V
#undef PG8_WAIT_L
#undef PG8_BAR
#undef PG8_SCHED
}
}

constexpr int BATCH = 4, SEQ = 8192, DM = 1024, DEPTH = 4, MTOK = BATCH * SEQ;
constexpr int NIN = 3584, DFF = 2816, NUP = 2 * DFF;
constexpr int COL_QA = 0, COL_KA = 256, COL_VA = 512, COL_QB = 768, COL_FZF = 1024, COL_FZB = 1280, COL_IB = 1536, COL_GB = 1792, COL_QC = 2048, COL_KC = 2560, COL_VC = 3072;
constexpr float EPS = 1e-6f;
constexpr int NWAVES = 8;
constexpr int MHALF = MTOK / 2;

constexpr size_t MiB = 1u << 20;
constexpr size_t WS_CTL = 0, CTL_ZERO_BYTES = 64 * 1024;
constexpr size_t WS_ROPE = 1 * MiB;
constexpr size_t WS_LBS = 1 * MiB + 640 * 1024;
constexpr size_t WS_LAM = WS_LBS + 16 * 1024;
constexpr size_t WS_RS = 1 * MiB + 768 * 1024;
constexpr size_t WS_WIN = 2 * MiB;
constexpr size_t WS_WOUT = 9 * MiB;
constexpr size_t WS_WUP = 11 * MiB;
constexpr size_t WS_WDN = 22 * MiB;
constexpr size_t WS_HD = 27 * MiB + 512 * 1024;
constexpr size_t WS_XN = 28 * MiB;
constexpr size_t WS_BIG = 92 * MiB;
constexpr size_t WS_ACT = WS_BIG;
constexpr size_t WS_HALO = WS_BIG + 176 * MiB;
constexpr size_t WS_BR = 356 * MiB;
constexpr size_t WS_X16 = WS_BR + 64 * MiB;
constexpr size_t WS_HS = WS_BR;
constexpr size_t WS_HO = WS_BR + 32 * MiB;
constexpr size_t WS_END = 484 * MiB;
constexpr int CW_BAR = 1024;

constexpr int RING_BYTES = 131072;
constexpr int LDSCTL_OFF = 148480, MISC_OFF = LDSCTL_OFF + 320;
constexpr int LDS_BYTES = 149504;

#define GAS __attribute__((address_space(1)))
#define LAS __attribute__((address_space(3)))
typedef unsigned short bf16_t;
typedef short bf16x8 __attribute__((ext_vector_type(8)));
typedef short s16x4 __attribute__((ext_vector_type(4)));
typedef float f32x4 __attribute__((ext_vector_type(4)));
typedef float f32x2 __attribute__((ext_vector_type(2)));
typedef float f32x16 __attribute__((ext_vector_type(16)));
typedef unsigned u32x4 __attribute__((ext_vector_type(4)));
typedef unsigned u32x2 __attribute__((ext_vector_type(2)));
typedef GAS unsigned gu32;
#define RLX_AGENT __ATOMIC_RELAXED, __HIP_MEMORY_SCOPE_AGENT
#define LDS_WAIT() asm volatile("s_waitcnt lgkmcnt(0)" ::: "memory")
#define VM_WAIT() asm volatile("s_waitcnt vmcnt(0)" ::: "memory")
#define MFMA32(a, b, c) __builtin_amdgcn_mfma_f32_32x32x16_bf16((a), (b), (c), 0, 0, 0)
__device__ __forceinline__ unsigned f2bf(float f) { unsigned u = __builtin_bit_cast(unsigned, f); return (u + 0x7fffu + ((u >> 16) & 1u)) >> 16; }
__device__ __forceinline__ unsigned pk2(float lo, float hi) { return f2bf(lo) | (f2bf(hi) << 16); }
__device__ __forceinline__ float bf2f(unsigned short b) { return __builtin_bit_cast(float, (unsigned)b << 16); }
typedef __bf16 bf16x2_t __attribute__((ext_vector_type(2)));
__device__ __forceinline__ unsigned cvtpk(float lo, float hi) { f32x2 v = {lo, hi}; bf16x2_t b = __builtin_convertvector(v, bf16x2_t); return __builtin_bit_cast(unsigned, b); }
__device__ __forceinline__ unsigned short f2bf1(float x) { return (unsigned short)(cvtpk(x, 0.f) & 0xffffu); }
__device__ __forceinline__ int crow(int r, int hi) { return (r & 3) + 8 * (r >> 2) + 4 * hi; }
typedef short v4i16_t __attribute__((ext_vector_type(4)));
__device__ __forceinline__ s16x4 vtr(const LAS unsigned char* p) { return __builtin_bit_cast(s16x4, __builtin_amdgcn_ds_read_tr16_b64_v4i16((LAS v4i16_t*)p)); }
__device__ __forceinline__ bf16x8 cat8(s16x4 lo, s16x4 hi) { return (bf16x8){lo[0], lo[1], lo[2], lo[3], hi[0], hi[1], hi[2], hi[3]}; }
__device__ __forceinline__ float wave_sum(float v) {
#pragma unroll
    for (int o = 1; o < 64; o <<= 1) v += __shfl_xor(v, o);
    return v;
}
#define MX3(a, b, c) __builtin_fmaxf(__builtin_fmaxf((a), (b)), (c))
__device__ __forceinline__ float xhalf_max(float m) { auto rr = __builtin_amdgcn_permlane32_swap(__float_as_uint(m), __float_as_uint(m), false, false); return __builtin_fmaxf(__uint_as_float(rr[0]), __uint_as_float(rr[1])); }
__device__ __forceinline__ float xhalf_sum(float m) { auto rr = __builtin_amdgcn_permlane32_swap(__float_as_uint(m), __float_as_uint(m), false, false); return __uint_as_float(rr[0]) + __uint_as_float(rr[1]); }
__device__ __forceinline__ int opaque_tid() { int t = threadIdx.x; asm volatile("" : "+v"(t)); return t; }
#define XB_TMO      128
#define XB_XCNT(j)  (256  + 64 * (j))
#define XB_XSUB(j)  (1280 + 64 * (j))
#define XB_XGEN(j)  (2304 + 64 * (j))
#define XB_TOP      3328
#define XB_TOPGEN   3392
#define XCD_BAR_WORDS 3456
#define XB_SPIN_CAP (1u << 18)

__device__ __forceinline__ unsigned xb_ld(unsigned* p)              { return __hip_atomic_load(p, __ATOMIC_RELAXED, __HIP_MEMORY_SCOPE_AGENT); }
__device__ __forceinline__ unsigned xb_add(unsigned* p, unsigned v) { return __hip_atomic_fetch_add(p, v, __ATOMIC_RELAXED, __HIP_MEMORY_SCOPE_AGENT); }
__device__ __forceinline__ unsigned xb_xcc_id() { return (unsigned)__builtin_amdgcn_s_getreg((3 << 11) | 20) & 0xFu; }
#define XB_SPIN(cond, bar) do { unsigned _sp = 0; while (cond) { __builtin_amdgcn_s_sleep(1); \
    if ((++_sp & 255u) == 0u) { if (xb_ld(&(bar)[XB_TMO])) break; if (_sp > XB_SPIN_CAP) { atomicAdd(&(bar)[XB_TMO], 1u); break; } } } } while (0)

struct XcdBarrier {
    unsigned* bar; unsigned x;
    volatile LAS unsigned* st;
};

__device__ __forceinline__ XcdBarrier xcd_barrier_post(unsigned* bar, volatile LAS unsigned* st) {
    XcdBarrier b; b.bar = bar; b.x = xb_xcc_id(); b.st = st;
    if (threadIdx.x == 0) (void)xb_add(&bar[XB_XCNT(b.x)], 1u);
    return b;
}
__device__ __forceinline__ void xcd_barrier_complete(unsigned* bar, unsigned x, unsigned& nloc, unsigned& nx) {
    const unsigned G = gridDim.x * gridDim.y * gridDim.z;
    unsigned sum, cnt, mine, sp = 0u;
    for (;;) {
        sum = 0u; cnt = 0u; mine = 0u;
        unsigned c0, c1, c2, c3, c4, c5, c6, c7, c8, c9, c10, c11, c12, c13, c14, c15; const unsigned* cp = &bar[XB_XCNT(0)];
        asm volatile("global_load_dword %0, %16, off sc1\n\tglobal_load_dword %1, %16, off offset:256 sc1\n\tglobal_load_dword %2, %16, off offset:512 sc1\n\tglobal_load_dword %3, %16, off offset:768 sc1\n\t"
                     "global_load_dword %4, %16, off offset:1024 sc1\n\tglobal_load_dword %5, %16, off offset:1280 sc1\n\tglobal_load_dword %6, %16, off offset:1536 sc1\n\tglobal_load_dword %7, %16, off offset:1792 sc1\n\t"
                     "global_load_dword %8, %16, off offset:2048 sc1\n\tglobal_load_dword %9, %16, off offset:2304 sc1\n\tglobal_load_dword %10, %16, off offset:2560 sc1\n\tglobal_load_dword %11, %16, off offset:2816 sc1\n\t"
                     "global_load_dword %12, %16, off offset:3072 sc1\n\tglobal_load_dword %13, %16, off offset:3328 sc1\n\tglobal_load_dword %14, %16, off offset:3584 sc1\n\tglobal_load_dword %15, %16, off offset:3840 sc1\n\t"
                     "s_waitcnt vmcnt(0)"
                     : "=&v"(c0), "=&v"(c1), "=&v"(c2), "=&v"(c3), "=&v"(c4), "=&v"(c5), "=&v"(c6), "=&v"(c7), "=&v"(c8), "=&v"(c9), "=&v"(c10), "=&v"(c11), "=&v"(c12), "=&v"(c13), "=&v"(c14), "=&v"(c15)
                     : "v"(cp) : "memory");
#define XB_CEN(j, c) { sum += (c); cnt += ((c) > 0u) ? 1u : 0u; mine = ((j) == x) ? (c) : mine; }
        XB_CEN(0u, c0) XB_CEN(1u, c1) XB_CEN(2u, c2) XB_CEN(3u, c3) XB_CEN(4u, c4) XB_CEN(5u, c5) XB_CEN(6u, c6) XB_CEN(7u, c7)
        XB_CEN(8u, c8) XB_CEN(9u, c9) XB_CEN(10u, c10) XB_CEN(11u, c11) XB_CEN(12u, c12) XB_CEN(13u, c13) XB_CEN(14u, c14) XB_CEN(15u, c15)
#undef XB_CEN
        if (sum == G) break;
        __builtin_amdgcn_s_sleep(1);
        if ((++sp & 255u) == 0u) { if (xb_ld(&bar[XB_TMO])) break; if (sp > XB_SPIN_CAP) { atomicAdd(&bar[XB_TMO], 1u); break; } }
    }
    nloc = mine > 0u ? mine : 1u; nx = cnt > 0u ? cnt : 1u;
}

__device__ __forceinline__ void xcd_barrier(const XcdBarrier& b) {
    asm volatile("s_waitcnt vmcnt(0)" ::: "memory");
    __syncthreads();
    if (threadIdx.x == 0) {
        unsigned* bar = b.bar; const unsigned bx = xb_xcc_id();
        __builtin_amdgcn_s_waitcnt(0);
        unsigned nloc = b.st[0], nx = b.st[1];
        if (nloc == 0u) { xcd_barrier_complete(bar, bx, nloc, nx); b.st[0] = nloc; b.st[1] = nx; }
        const unsigned old = xb_add(&bar[XB_XSUB(bx)], 1u);
        const unsigned gen = old / nloc;
        if (old + 1u == (gen + 1u) * nloc) {
            __builtin_amdgcn_fence(__ATOMIC_RELEASE, "agent");
            asm volatile("s_waitcnt vmcnt(0)" ::: "memory");
            const unsigned og = xb_add(&bar[XB_TOP], 1u);
            const unsigned tg = og / nx;
            if (og + 1u == (tg + 1u) * nx) xb_add(&bar[XB_TOPGEN], 1u);
            else XB_SPIN(xb_ld(&bar[XB_TOPGEN]) == tg, bar);
            __builtin_amdgcn_fence(__ATOMIC_ACQUIRE, "agent");
            xb_add(&bar[XB_XGEN(bx)], 1u);
            asm volatile("s_waitcnt vmcnt(0)" ::: "memory");
        } else {
            XB_SPIN(xb_ld(&bar[XB_XGEN(bx)]) == gen, bar);
            __builtin_amdgcn_fence(__ATOMIC_ACQUIRE, "agent");
            asm volatile("s_waitcnt vmcnt(0)" ::: "memory");
        }
    }
    __syncthreads();
}

struct Frame {
    LAS unsigned char* lds;
    int wave;
    int vcu, G;
    unsigned char* ws;
};

__device__ __forceinline__ void prologue_small(Frame& F, const float* lb_logits, const float* diff_lambda) {
    const int L_tid = opaque_tid(), L_lane = L_tid & 63;
    const int gt = F.vcu * (NWAVES * 64) + L_tid, NT = F.G * NWAVES * 64;
    float* rope = (float*)(F.ws + WS_ROPE);
    for (int i = gt; i < SEQ * 8; i += NT) {
        const int pos = i >> 3, j = i & 7;
        const double inv = (j == 0) ? 1.0 : (j == 1) ? 0.19392274474868576 : (j == 2) ? 0.03760603093086393 : (j == 3) ? 0.007292664737217109 : (j == 4) ? 0.001414213562373095
                         : (j == 5) ? 0.0002742481756762073 : (j == 6) ? 5.318295896944988e-05 : 1.031338537721246e-05;
        const double rev = (double)pos * inv * 0.15915494309189535;
        const double fr = rev - __builtin_rint(rev);
        const float f = (float)fr;
        rope[pos * 16 + j] = __builtin_amdgcn_cosf(f);
        rope[pos * 16 + 8 + j] = __builtin_amdgcn_sinf(f);
    }
    float* lbs = (float*)(F.ws + WS_LBS);
    for (int i = gt; i < 2 * 256; i += NT) {
        const int dir = i >> 8, c = i & 255;
        float z[DEPTH], mx = -1e30f;
#pragma unroll
        for (int l = 0; l < DEPTH; ++l) { z[l] = lb_logits[(dir * DEPTH + l) * 256 + c]; mx = fmaxf(mx, z[l]); }
        float s = 0.f;
#pragma unroll
        for (int l = 0; l < DEPTH; ++l) { z[l] = __expf(z[l] - mx); s += z[l]; }
        const float is = 1.f / s; float cum = 0.f;
#pragma unroll
        for (int l = 0; l < DEPTH; ++l) { const float p = z[l] * is; cum += p; lbs[(dir * DEPTH + l) * 256 + c] = cum - z[0] * is; }
    }
    if (gt < DEPTH) {
        const float* lp = diff_lambda + gt * 256;
        float s1 = 0.f, s2 = 0.f;
        for (int d = 0; d < 64; ++d) { s1 += lp[d] * lp[64 + d]; s2 += lp[128 + d] * lp[192 + d]; }
        const float lam_init = 0.8f - 0.6f * expf(-0.3f * (float)gt);
        ((float*)(F.ws + WS_LAM))[gt] = expf(s1) - expf(s2) + lam_init;
    }
}

template <bool GATEVAL, bool ROPEPERM = false>
__device__ __forceinline__ void transpose_item(const float* W, int K, int N, bf16_t* WT, LAS float* scr, int item, int lane, const float* gain) {
    const int nblk = N / 32, kb = item / nblk, nb = item % nblk, k0 = 64 * kb, n0 = 32 * nb;
    { float wv[32], gv[32];
#pragma unroll
      for (int i = 0; i < 32; ++i) { const int kk = 2 * i + (lane >> 5); gv[i] = gain ? gain[k0 + kk] : 1.f; wv[i] = W[(size_t)(k0 + kk) * N + n0 + (lane & 31)]; }
#pragma unroll
      for (int i = 0; i < 32; ++i) { const int kk = 2 * i + (lane >> 5); scr[kk * 33 + (lane & 31)] = wv[i] * gv[i]; } }
    LDS_WAIT(); asm volatile("" ::: "memory");
    const int c = lane & 7;
#pragma unroll
    for (int j = 0; j < 4; ++j) { const int n = (lane >> 3) + 8 * j; const LAS float* s = scr + (8 * c) * 33 + n;
        u32x4 o; o.x = cvtpk(s[0 * 33], s[1 * 33]); o.y = cvtpk(s[2 * 33], s[3 * 33]); o.z = cvtpk(s[4 * 33], s[5 * 33]); o.w = cvtpk(s[6 * 33], s[7 * 33]);
        int orow = n0 + n;
        if (ROPEPERM) { const bool rt = (orow < 2 * 256) || (orow >= 8 * 256 && orow < 12 * 256); const int p = orow & 63; if (rt && p >= 4 && p < 12) orow += (p < 8) ? 4 : -4; }
        if (GATEVAL) { const int isv = orow >= DFF, cc = isv ? orow - DFF : orow; orow = 256 * (cc >> 7) + 128 * isv + (cc & 127); }
        *(GAS u32x4*)(WT + (size_t)orow * K + k0 + 8 * c) = o; }
    LDS_WAIT(); asm volatile("" ::: "memory");
}
__device__ __forceinline__ void convert_weights(Frame& F, const float* w_in, const float* w_out, const float* w_up, const float* w_down, const float* g_in, const float* g_up) {
    const int L_tid = opaque_tid(), L_lane = L_tid & 63;
    LAS float* scr = (LAS float*)(F.lds + F.wave * 16384);
    const int gw = F.vcu * NWAVES + F.wave, NGW = F.G * NWAVES;
    constexpr int I_IN = (DM / 64) * (NIN / 32), I_OUT = (DM / 64) * (DM / 32), I_UP = (DM / 64) * (NUP / 32), I_DN = (DFF / 64) * (DM / 32);
    constexpr int NITEMS = I_IN + I_OUT + I_UP + I_DN;
    for (int it = gw; it < NITEMS; it += NGW) {
        int r = it;
        if (r < I_IN) { transpose_item<false, true>(w_in, DM, NIN, (bf16_t*)(F.ws + WS_WIN), scr, r, L_lane, g_in); continue; } r -= I_IN;
        if (r < I_OUT) { transpose_item<false>(w_out, DM, DM, (bf16_t*)(F.ws + WS_WOUT), scr, r, L_lane, nullptr); continue; } r -= I_OUT;
        if (r < I_UP) { transpose_item<true>(w_up, DM, NUP, (bf16_t*)(F.ws + WS_WUP), scr, r, L_lane, g_up); continue; } r -= I_UP;
        transpose_item<false>(w_down, DFF, DM, (bf16_t*)(F.ws + WS_WDN), scr, r, L_lane, nullptr);
    }
}

__device__ __forceinline__ void unpack8(const u32x4 b, f32x4& lo, f32x4& hi) {
    lo = (f32x4){bf2f((unsigned short)(b.x & 0xffffu)), bf2f((unsigned short)(b.x >> 16)), bf2f((unsigned short)(b.y & 0xffffu)), bf2f((unsigned short)(b.y >> 16))};
    hi = (f32x4){bf2f((unsigned short)(b.z & 0xffffu)), bf2f((unsigned short)(b.z >> 16)), bf2f((unsigned short)(b.w & 0xffffu)), bf2f((unsigned short)(b.w >> 16))};
}
__device__ __forceinline__ void init_rows(Frame& F, const float* x, bf16_t* x16, float* rs) {
    const int L_tid = opaque_tid(), L_lane = L_tid & 63;
    const int gw = F.vcu * NWAVES + F.wave, NGW = F.G * NWAVES;
    for (int m0 = gw; m0 < MTOK; m0 += 4 * NGW) {
        f32x4 v[4][4];
#pragma unroll
        for (int q = 0; q < 4; ++q) { const int m = (m0 + q * NGW < MTOK) ? m0 + q * NGW : m0; const f32x4* xr = (const f32x4*)(x + (size_t)m * DM) + 2 * L_lane;
            v[q][0] = xr[0]; v[q][1] = xr[1]; v[q][2] = xr[128]; v[q][3] = xr[129]; }
#pragma unroll
        for (int q = 0; q < 4; ++q) { const int m = m0 + q * NGW;
            float s = 0.f;
#pragma unroll
            for (int j = 0; j < 4; ++j) s += (v[q][j].x * v[q][j].x + v[q][j].y * v[q][j].y) + (v[q][j].z * v[q][j].z + v[q][j].w * v[q][j].w);
            const float r = wave_sum(s);
            if (m < MTOK) {
                u32x4* o16 = (u32x4*)(x16 + (size_t)m * DM) + L_lane;
#pragma unroll
                for (int j = 0; j < 2; ++j) { u32x4 w; w.x = cvtpk(v[q][2 * j].x, v[q][2 * j].y); w.y = cvtpk(v[q][2 * j].z, v[q][2 * j].w); w.z = cvtpk(v[q][2 * j + 1].x, v[q][2 * j + 1].y); w.w = cvtpk(v[q][2 * j + 1].z, v[q][2 * j + 1].w); o16[64 * j] = w; }
                if (L_lane < 4) rs[(size_t)m * 4 + L_lane] = (L_lane == 0) ? r : 0.f;
            }
        }
    }
}
__device__ __forceinline__ void post_row_load(const bf16_t* br, const bf16_t* x16, int m, int lane, u32x4 (&b)[2], u32x4 (&xb)[2]) {
    const u32x4* brr = (const u32x4*)(br + (size_t)m * DM) + lane;
    const u32x4* xr = (const u32x4*)(x16 + (size_t)m * DM) + lane;
    b[0] = brr[0]; b[1] = brr[64]; xb[0] = xr[0]; xb[1] = xr[64];
}
__device__ __forceinline__ void post_row_finish(const u32x4 (&b)[2], const u32x4 (&xb)[2], bf16_t* x16, float* rs, float* out32, const float* gpost, int m, int lane) {
    f32x4 v[4], xv[4]; float s = 0.f;
    unpack8(b[0], v[0], v[1]); unpack8(b[1], v[2], v[3]); unpack8(xb[0], xv[0], xv[1]); unpack8(xb[1], xv[2], xv[3]);
#pragma unroll
    for (int j = 0; j < 4; ++j) s += (v[j].x * v[j].x + v[j].y * v[j].y) + (v[j].z * v[j].z + v[j].w * v[j].w);
    const float r = 1.f / sqrtf(wave_sum(s) * (1.f / DM) + EPS);
    float s2 = 0.f;
#pragma unroll
    for (int j = 0; j < 4; ++j) { const f32x4 gp = *(const f32x4*)(gpost + 8 * lane + 512 * (j >> 1) + 4 * (j & 1)); xv[j] = xv[j] + v[j] * r * gp;
        s2 += (xv[j].x * xv[j].x + xv[j].y * xv[j].y) + (xv[j].z * xv[j].z + xv[j].w * xv[j].w); }
    if (out32) {
        f32x4* xo = (f32x4*)(out32 + (size_t)m * DM) + 2 * lane;
#pragma unroll
        for (int j = 0; j < 4; ++j) xo[128 * (j >> 1) + (j & 1)] = xv[j];
    } else {
        const float r2 = 1.f / sqrtf(wave_sum(s2) * (1.f / DM) + EPS);
        u32x4* o16 = (u32x4*)(x16 + (size_t)m * DM) + lane;
#pragma unroll
        for (int j = 0; j < 2; ++j) { u32x4 w; w.x = cvtpk(xv[2 * j].x, xv[2 * j].y); w.y = cvtpk(xv[2 * j].z, xv[2 * j].w); w.z = cvtpk(xv[2 * j + 1].x, xv[2 * j + 1].y); w.w = cvtpk(xv[2 * j + 1].z, xv[2 * j + 1].w); o16[64 * j] = w; }
        if (lane == 0) rs[m] = r2;
    }
}
__device__ __forceinline__ void post_rows(Frame& F, const bf16_t* br, bf16_t* x16, float* rs, float* out32, const float* gpost) {
    const int L_tid = opaque_tid(), L_lane = L_tid & 63;
    const int gw = F.vcu * NWAVES + F.wave, NGW = F.G * NWAVES;
    for (int m = gw; m < MTOK; m += 4 * NGW) {
        u32x4 b[4][2], xx[4][2];
#pragma unroll
        for (int q = 0; q < 4; ++q) if (m + q * NGW < MTOK) post_row_load(br, x16, m + q * NGW, L_lane, b[q], xx[q]);
#pragma unroll
        for (int q = 0; q < 4; ++q) if (m + q * NGW < MTOK) post_row_finish(b[q], xx[q], x16, rs, out32, gpost, m + q * NGW, L_lane);
    }
}

__device__ __forceinline__ f32x4 ld4bf(const bf16_t* p) { const u32x2 u = *(const u32x2*)p; return (f32x4){bf2f((unsigned short)(u.x & 0xffffu)), bf2f((unsigned short)(u.x >> 16)), bf2f((unsigned short)(u.y & 0xffffu)), bf2f((unsigned short)(u.y >> 16))}; }
__device__ __forceinline__ void conv_fixup(Frame& F, const bf16_t* halo, bf16_t* act, const float* cw, const float* cb) {
    const int L_tid = opaque_tid();
    const int gt = F.vcu * (NWAVES * 64) + L_tid, NT = F.G * NWAVES * 64;
    constexpr int CG = DFF / 4, NBLK = MTOK / 64;
    constexpr int NIT = CG * NBLK * 2;
    for (int it0 = gt; it0 < NIT; it0 += 3 * NT) {
        u32x2 h[3][6]; f32x4 wv[3][8]; int rowc[3];
#pragma unroll
        for (int q = 0; q < 3; ++q) {
            const int it = (it0 + q * NT < NIT) ? it0 + q * NT : it0;
            const int cg = it % CG, rb = it / CG, blk = rb >> 1, last = rb & 1, c = cg * 4;
            rowc[q] = (blk * 64 + (last ? 63 : 0)) * DFF + c;
            const bf16_t* hc = halo + ((size_t)blk * 4 + (last ? 3 : 0)) * NUP + c;
            const bool nop = (!last) && ((blk & (SEQ / 64 - 1)) == 0), non = last && ((blk & (SEQ / 64 - 1)) == SEQ / 64 - 1);
            const bf16_t* hp = nop ? hc : last ? halo + ((size_t)blk * 4 + 2) * NUP + c : halo + ((size_t)(blk - 1) * 4 + 3) * NUP + c;
            const bf16_t* hn = non ? hc : last ? halo + ((size_t)(blk + 1) * 4 + 0) * NUP + c : halo + ((size_t)blk * 4 + 1) * NUP + c;
            const unsigned mp = nop ? 0u : 0xffffffffu, mn = non ? 0u : 0xffffffffu;
            h[q][0] = *(const u32x2*)hp & mp; h[q][1] = *(const u32x2*)(hp + DFF) & mp; h[q][2] = *(const u32x2*)hn & mn; h[q][3] = *(const u32x2*)(hn + DFF) & mn;
            h[q][4] = *(const u32x2*)hc; h[q][5] = *(const u32x2*)(hc + DFF);
            wv[q][0] = *(const f32x4*)(cw + c); wv[q][1] = *(const f32x4*)(cw + NUP + c); wv[q][2] = *(const f32x4*)(cw + 2 * NUP + c); wv[q][3] = *(const f32x4*)(cb + c);
            wv[q][4] = *(const f32x4*)(cw + DFF + c); wv[q][5] = *(const f32x4*)(cw + NUP + DFF + c); wv[q][6] = *(const f32x4*)(cw + 2 * NUP + DFF + c); wv[q][7] = *(const f32x4*)(cb + DFF + c);
        }
#pragma unroll
        for (int q = 0; q < 3; ++q) {
#define FX_U(u) ((f32x4){bf2f((unsigned short)((u).x & 0xffffu)), bf2f((unsigned short)((u).x >> 16)), bf2f((unsigned short)((u).y & 0xffffu)), bf2f((unsigned short)((u).y >> 16))})
            const f32x4 Gp = FX_U(h[q][0]), Vp = FX_U(h[q][1]), Gn = FX_U(h[q][2]), Vn = FX_U(h[q][3]), G = FX_U(h[q][4]), V = FX_U(h[q][5]);
#undef FX_U
            const f32x4 g = Gp * wv[q][0] + G * wv[q][1] + Gn * wv[q][2] + wv[q][3];
            const f32x4 v = Vp * wv[q][4] + V * wv[q][5] + Vn * wv[q][6] + wv[q][7];
            f32x4 sg;
#pragma unroll
            for (int j = 0; j < 4; ++j) sg[j] = __builtin_amdgcn_rcpf(1.f + __expf(-g[j]));
            const f32x4 o = g * sg * v;
            u32x2 w; w.x = cvtpk(o[0], o[1]); w.y = cvtpk(o[2], o[3]);
            if (it0 + q * NT < NIT) *(u32x2*)(act + (size_t)rowc[q]) = w;
        }
    }
}

constexpr float C_THR = 8.f;
constexpr int C_SLOT = 16384, C_VREG = 4 * C_SLOT, C_WSF = 8 * C_SLOT;
template <int VAR>
__device__ __forceinline__ void diffattn_unit(int bh, int qb, const bf16_t* proj, bf16_t* mixcat, LAS unsigned char* lds, const float* lamp, float outscale, const float* diff_g) {
    const int tid = opaque_tid(), lane = tid & 63, r32 = lane & 31, hi = lane >> 5; const int wid = __builtin_amdgcn_readfirstlane(tid >> 6);
    const int cmap = wid >> 2, wq = wid & 3;
    const int b = bh >> 2, h = bh & 3;
    const size_t rowbase = (size_t)b * SEQ; const int q0 = qb * 128;
    LAS float* wsf = (LAS float*)(lds + C_WSF) + wid * 128;
    bf16x8 qr[4];
    { const bf16_t* Qw = proj + (rowbase + q0 + wq * 32 + r32) * NIN + COL_QC + h * 128 + cmap * 64;
#pragma unroll
      for (int d0 = 0; d0 < 4; ++d0) qr[d0] = *(const bf16x8*)(Qw + d0 * 16 + hi * 8); }
    const unsigned kgo = (unsigned)(((4 * wid + (lane >> 4)) * NIN + COL_KC + h * 128 + (((lane & 15) ^ ((4 * wid + (lane >> 4)) & 15)) * 8)) * 2);
    const unsigned vgo = (unsigned)(((8 * (wid >> 1) + ((lane >> 2) & 7)) * NIN + COL_VC + h * 128 + (wid & 1) * 64 + (lane >> 5) * 32 + (lane & 3) * 8) * 2);
    const char* pbase = (const char*)(proj + rowbase * NIN);
    const int kdst = wid * 1024, vdst = C_VREG + (wid >> 1) * 2048 + (wid & 1) * 1024;
    constexpr int NT = SEQ / 64;
    const unsigned ldsb = (unsigned)(uintptr_t)lds;
#define C_GLDS(voff, sbase, ldsaddr) do { unsigned keep_; asm volatile("s_mov_b32 %0, m0\n\ts_mov_b32 m0, %3\n\ts_nop 0\n\tglobal_load_lds_dwordx4 %1, %2\n\ts_mov_b32 m0, %0" \
        : "=&s"(keep_) : "v"(voff), "s"(sbase), "s"((unsigned)__builtin_amdgcn_readfirstlane((int)(ldsaddr))) : "memory"); } while (0)
#define C_DMAK(tile) do { const char* sb_ = pbase + (size_t)((tile) & (NT - 1)) * (64 * NIN * 2); const unsigned sl_ = ldsb + ((tile) & 3) * C_SLOT + kdst; C_GLDS(kgo, sb_, sl_); C_GLDS(kgo, sb_ + 32 * NIN * 2, sl_ + 8192); } while (0)
#define C_DMAV(tile) do { const char* sb_ = pbase + (size_t)((tile) & (NT - 1)) * (64 * NIN * 2); const unsigned sl_ = ldsb + ((tile) & 3) * C_SLOT + vdst; C_GLDS(vgo, sb_, sl_); C_GLDS(vgo, sb_ + 32 * NIN * 2, sl_ + 8192); } while (0)
    int kof[4];
#pragma unroll
    for (int d0 = 0; d0 < 4; ++d0) kof[d0] = r32 * 256 + (((8 * cmap + 2 * d0 + hi) ^ (r32 & 15)) * 16);
    const LAS unsigned char* vp0 = lds + C_VREG + ((lane >> 4) & 1) * 32 + (lane & 3) * 8 + (4 * hi + ((lane & 15) >> 2)) * 64;
    f32x16 o[4];
#pragma unroll
    for (int d0 = 0; d0 < 4; ++d0) o[d0] = f32x16{};
    float mrun, lrun = 0.f;
    C_DMAK(0); C_DMAV(0); C_DMAK(1); C_DMAV(1); C_DMAK(2); C_DMAV(2); C_DMAK(3);
    VM_WAIT();
    __syncthreads();
    f32x16 p0 = f32x16{}, p1 = f32x16{};
#pragma unroll
    for (int d0 = 0; d0 < 4; ++d0) {
        const bf16x8 k0 = *(const LAS bf16x8*)(lds + kof[d0]), k1 = *(const LAS bf16x8*)(lds + kof[d0] + 8192);
        p0 = MFMA32(k0, qr[d0], p0); p1 = MFMA32(k1, qr[d0], p1);
    }
    { float a = MX3(p0[0], p0[1], p1[0]), bb = MX3(p0[2], p0[3], p1[1]); a = MX3(a, p1[2], p1[3]);
#pragma unroll
      for (int r = 4; r < 16; r += 4) { a = MX3(a, p0[r], p0[r + 1]); bb = MX3(bb, p0[r + 2], p0[r + 3]); a = MX3(a, p1[r], p1[r + 1]); bb = MX3(bb, p1[r + 2], p1[r + 3]); }
      mrun = xhalf_max(__builtin_fmaxf(a, bb));
#pragma unroll
      for (int r = 0; r < 16; ++r) { p0[r] = __builtin_amdgcn_exp2f(p0[r] - mrun); p1[r] = __builtin_amdgcn_exp2f(p1[r] - mrun); } }
    f32x16 negm;
#pragma unroll
    for (int r = 0; r < 16; ++r) negm[r] = -mrun;
    bf16x8 kfe[4];
#pragma unroll
    for (int i = 0; i < 4; ++i) kfe[i] = *(const LAS bf16x8*)(lds + C_SLOT + kof[i >> 1] + (i & 1) * 8192);
    if ((VAR & 512) && wid >= 4) __builtin_amdgcn_s_sleep(8);
    for (int t = (((VAR & 64) && wid >= 4) || (VAR & 1024)) ? NT : 0; t < NT; ++t) {
        f32x16 n0, n1;
        u32x4 pw[4];
        float sacc = 0.f;
        const LAS unsigned char* kq = lds + ((t + 1) & 3) * C_SLOT;
        const LAS unsigned char* kq2 = lds + ((t + 2) & 3) * C_SLOT;
        const LAS unsigned char* vq = vp0 + (t & 3) * C_SLOT;
        bf16x8 kf[8], vf[8];
#pragma unroll
        for (int i = 0; i < 4; ++i) kf[i] = kfe[i];
#pragma unroll
        for (int i = 4; i < 8; ++i) kf[i] = *(const LAS bf16x8*)(kq + kof[i >> 1] + (i & 1) * 8192);
#define C_VFRAG(i) cat8(vtr(vq + ((i) >> 2) * 4096 + ((i) & 3) * 512), vtr(vq + ((i) >> 2) * 4096 + ((i) & 3) * 512 + 2048))
#define C_GA(i, ACC, FIRST, PP, B) do { \
            vf[i] = C_VFRAG(i); \
            if (!(VAR & 32)) { ACC = FIRST ? MFMA32(kf[i], qr[(i) >> 1], negm) : MFMA32(kf[i], qr[(i) >> 1], ACC); } else if (FIRST) { ACC = f32x16{}; ACC[0] = __builtin_bit_cast(float, (int)kf[i][0]); } \
            if (!(VAR & 4)) { sacc += PP[B]; sacc += PP[B + 1]; sacc += PP[B + 2]; sacc += PP[B + 3]; asm volatile("" : "+v"(sacc)); \
            pw[(i) >> 1][2 * ((i) & 1)] = cvtpk(PP[B], PP[B + 1]); pw[(i) >> 1][2 * ((i) & 1) + 1] = cvtpk(PP[B + 2], PP[B + 3]); asm volatile("" : "+v"(pw[(i) >> 1])); } \
            else { pw[(i) >> 1][2 * ((i) & 1)] = __builtin_bit_cast(unsigned, PP[B]); pw[(i) >> 1][2 * ((i) & 1) + 1] = __builtin_bit_cast(unsigned, PP[B + 2]); } \
            __builtin_amdgcn_sched_barrier(0); } while (0)
        C_GA(0, n0, true, p0, 0);  C_GA(1, n1, true, p0, 4);  C_GA(2, n0, false, p0, 8); C_GA(3, n1, false, p0, 12);
        C_GA(4, n0, false, p1, 0); C_GA(5, n1, false, p1, 4); C_GA(6, n0, false, p1, 8); C_GA(7, n1, false, p1, 12);
#undef C_GA
        lrun += sacc;
        if (!(VAR & 1)) { C_DMAK(t + 4); C_DMAV(t + 3); }
        float mxa, mxb;
#define C_GB(i) do { \
            o[(i) & 3] = MFMA32(__builtin_bit_cast(bf16x8, pw[(i) >> 2]), vf[(i) & 7], o[(i) & 3]); \
            if ((i) < 8) vf[(i) & 7] = C_VFRAG((i) + 8); \
            if ((i) >= 8 && (i) < 12) kfe[(i) - 8] = *(const LAS bf16x8*)(kq2 + kof[((i) - 8) >> 1] + (((i) - 8) & 1) * 8192); \
            if ((i) < 4) { const int c_ = 4 * (i); \
                if ((i) == 0) { mxa = MX3(n0[0], n0[1], n1[0]); mxb = MX3(n0[2], n0[3], n1[1]); mxa = MX3(mxa, n1[2], n1[3]); } \
                else { mxa = MX3(mxa, n0[c_], n0[c_ + 1]); mxb = MX3(mxb, n0[c_ + 2], n0[c_ + 3]); mxa = MX3(mxa, n1[c_], n1[c_ + 1]); mxb = MX3(mxb, n1[c_ + 2], n1[c_ + 3]); } \
                asm volatile("" : "+v"(mxa), "+v"(mxb)); } \
            __builtin_amdgcn_sched_barrier(0); } while (0)
#define C_EX(e) do { float e0 = (VAR & 2) ? n0[e] : __builtin_amdgcn_exp2f(n0[e]), e1 = (VAR & 2) ? n1[e] : __builtin_amdgcn_exp2f(n1[e]); asm volatile("" : "+v"(e0), "+v"(e1)); p0[e] = e0; p1[e] = e1; } while (0)
#define C_GBX(i, ea, eb) do { \
            o[(i) & 3] = MFMA32(__builtin_bit_cast(bf16x8, pw[(i) >> 2]), vf[(i) & 7], o[(i) & 3]); \
            if ((i) < 8) vf[(i) & 7] = C_VFRAG((i) + 8); \
            if ((i) >= 8 && (i) < 12) kfe[(i) - 8] = *(const LAS bf16x8*)(kq2 + kof[((i) - 8) >> 1] + (((i) - 8) & 1) * 8192); \
            C_EX(ea); if ((eb) >= 0) C_EX((eb) < 0 ? 0 : (eb)); \
            __builtin_amdgcn_sched_barrier(0); } while (0)
        C_GB(0); C_GB(1); C_GB(2); C_GB(3);
        float rm; asm("v_max_f32 %0, %1, %2" : "=v"(rm) : "v"(mxa), "v"(mxb));
        const bool need = __any(rm > C_THR);
        __builtin_amdgcn_sched_barrier(0);
        C_GBX(4, 0, 1); C_GBX(5, 2, 3); C_GBX(6, 4, 5); C_GBX(7, 6, 7);
        C_GBX(8, 8, -1); C_GBX(9, 9, -1); C_GBX(10, 10, -1); C_GBX(11, 11, -1); C_GBX(12, 12, -1); C_GBX(13, 13, -1); C_GBX(14, 14, -1); C_GBX(15, 15, -1);
#undef C_GBX
#undef C_EX
#undef C_GB
#undef C_VFRAG
        if (need) {
            const float dl = -__builtin_fmaxf(xhalf_max(rm), 0.f), al = __builtin_amdgcn_exp2f(dl);
            mrun -= dl; lrun *= al;
#pragma unroll
            for (int r = 0; r < 16; ++r) { negm[r] = -mrun; p0[r] = __builtin_amdgcn_exp2f(n0[r] + dl); p1[r] = __builtin_amdgcn_exp2f(n1[r] + dl); }
            if (hi == 0) wsf[r32] = al;
            LDS_WAIT();
#pragma unroll
            for (int g = 0; g < 4; ++g) { const f32x4 a4 = *(const LAS f32x4*)(wsf + 8 * g + 4 * hi);
#pragma unroll
                for (int d0 = 0; d0 < 4; ++d0)
#pragma unroll
                    for (int j = 0; j < 4; ++j) o[d0][4 * g + j] *= a4[j]; }
        }
        asm volatile("s_waitcnt vmcnt(4)" ::: "memory");
        if (!(VAR & 8)) __syncthreads();
    }
    VM_WAIT();
    __syncthreads();
#undef C_DMAK
#undef C_DMAV
#undef C_GLDS
    { const float lt = xhalf_sum(lrun);
      const float sc = (cmap ? *lamp : 1.f) / lt;
      if (hi == 0) wsf[r32] = sc;
      LDS_WAIT();
      LAS float* xb = (LAS float*)(lds + wq * 16384) + lane;
#pragma unroll
      for (int g = 0; g < 4; ++g) { const f32x4 s4 = *(const LAS f32x4*)(wsf + 8 * g + 4 * hi);
#pragma unroll
          for (int d0 = 0; d0 < 4; ++d0)
#pragma unroll
              for (int j = 0; j < 4; ++j) o[d0][4 * g + j] *= s4[j]; }
      if (cmap == 1) {
#pragma unroll
          for (int d0 = 0; d0 < 4; ++d0)
#pragma unroll
              for (int rr = 0; rr < 16; ++rr) xb[(d0 * 16 + rr) * 64] = o[d0][rr];
      }
      __syncthreads();
      if (cmap == 0) {
          float gd[4];
#pragma unroll
          for (int d0 = 0; d0 < 4; ++d0) gd[d0] = diff_g[32 * d0 + r32] * outscale;
          bf16_t* Ow = mixcat + (rowbase + q0 + wq * 32) * DM + 512 + h * 128 + r32;
#pragma unroll
          for (int rr = 0; rr < 16; ++rr) {
              float v[4], ss = 0.f;
#pragma unroll
              for (int d0 = 0; d0 < 4; ++d0) { v[d0] = o[d0][rr] - xb[(d0 * 16 + rr) * 64]; ss += v[d0] * v[d0]; }
#pragma unroll
              for (int s = 1; s < 32; s <<= 1) ss += __shfl_xor(ss, s);
              const float rs = 1.f / sqrtf(ss * (1.f / 128.f) + EPS);
              const int row = crow(rr, hi);
#pragma unroll
              for (int d0 = 0; d0 < 4; ++d0) Ow[(size_t)row * DM + 32 * d0] = f2bf1(v[d0] * rs * gd[d0]);
          }
      }
      __syncthreads();
    }
}
template <int VAR>
__device__ __forceinline__ void diffattn_phase(Frame& F, const bf16_t* proj, bf16_t* mixcat, const float* lamp, float outscale, const float* diff_g) {
    for (int u = F.vcu; u < BATCH * 4 * (SEQ / 128); u += F.G) diffattn_unit<VAR>(u >> 6, u & 63, proj, mixcat, F.lds, lamp, outscale, diff_g);
}

constexpr int A_OST = 0, A_ML = 65536, A_WV = 69632, A_WVB = 8704;
template <int D, bool FIRST, bool LAST, int VAR = 0>
__device__ __forceinline__ void dilated_task(int b, int h, int P0, int j, const bf16_t* proj, bf16_t* mixcat, LAS unsigned char* lds, LAS unsigned char* wlds) {
    const int lane = opaque_tid() & 63, r32 = lane & 31, hi = lane >> 5;
    constexpr int NB = 16 / D, L = SEQ / D;
    const int rho = j / NB, blk = j % NB;
    const int lb0 = P0 / D + 32 * blk;
    const size_t rowbase = (size_t)b * SEQ;
    LAS float* wsf = (LAS float*)(wlds + 4096);
    LAS float* mst = (LAS float*)(lds + A_ML); LAS float* lst = mst + 512;
    const int plq = (32 * blk + r32) * D + rho;
    const int plo = (32 * blk + 4 * hi) * D + rho;
    LAS unsigned char* ktile = wlds + 4608;
    const int kwr = (lane >> 3) * 128 + (((lane & 7) ^ ((lane >> 3) & 7)) * 16);
    int kfo[4];
#pragma unroll
    for (int d0 = 0; d0 < 4; ++d0) kfo[d0] = r32 * 128 + (((2 * d0 + hi) ^ (r32 & 7)) * 16);
    bf16x8 qr[4];
    { const bf16_t* Qg = proj + (rowbase + ((VAR & 1) ? 0 : P0 + (32 * blk + (lane >> 3)) * D + rho)) * ((VAR & 8) ? 768 : NIN) + COL_QA + h * 64 + (lane & 7) * 8;
      u32x4 qs[4];
#pragma unroll
      for (int j = 0; j < 4; ++j) qs[j] = *(const u32x4*)(Qg + (size_t)((VAR & 1) ? 0 : 8 * j * D) * ((VAR & 8) ? 768 : NIN));
#pragma unroll
      for (int j = 0; j < 4; ++j) *(LAS u32x4*)(ktile + kwr + j * 1024) = qs[j];
      LDS_WAIT();
#pragma unroll
      for (int d0 = 0; d0 < 4; ++d0) qr[d0] = *(const LAS bf16x8*)(ktile + kfo[d0]);
      LDS_WAIT(); }
    const bf16_t* Kb = proj + (rowbase + rho) * NIN + COL_KA + h * 64 + (lane & 7) * 8;
    const bf16_t* Vb = proj + (rowbase + rho) * NIN + COL_VA + h * 64 + (lane & 7) * 8;
    f32x16 o[2]; float mrun, lrun;
    if (FIRST || (VAR & 4)) { o[0] = f32x16{}; o[1] = f32x16{}; mrun = -1e30f; lrun = 0.f; }
    else {
        mrun = mst[plq]; lrun = hi ? 0.f : lst[plq];
#pragma unroll
        for (int d0 = 0; d0 < 2; ++d0)
#pragma unroll
            for (int rr = 0; rr < 16; ++rr) o[d0][rr] = bf2f(*(const LAS bf16_t*)(lds + A_OST + (plo + ((rr & 3) + 8 * (rr >> 2)) * D) * 128 + (32 * d0 + r32) * 2));
    }
    u32x4 kst[3][4], vst[2][4];
    const int vw = ((lane & 7) >> 2) * 2048 + (lane >> 3) * 64 + (lane & 3) * 16;
    const LAS unsigned char* vp0 = wlds + ((lane >> 4) & 1) * 32 + (lane & 3) * 8 + (4 * hi + ((lane & 15) >> 2)) * 64;
#pragma unroll
#define A_LOADK(kb, S) do { _Pragma("unroll") for (int j = 0; j < 4; ++j) { int lk = lb0 - 64 + 32 * (kb) + (lane >> 3) + 8 * j; lk = lk < 0 ? 0 : (lk >= L ? L - 1 : lk); \
            kst[S][j] = *(const u32x4*)(Kb + (size_t)((VAR & 1) ? 0 : lk * D) * ((VAR & 8) ? 768 : NIN)); } } while (0)
    A_LOADK(0, 0); A_LOADK(1, 1); A_LOADK(2, 2);
#define A_LOADV(kb, S) do { _Pragma("unroll") for (int q = 0; q < 4; ++q) { int lk = lb0 - 64 + 32 * (kb) + (lane >> 3) + 8 * q; lk = lk < 0 ? 0 : (lk >= L ? L - 1 : lk); \
          vst[S][q] = *(const u32x4*)(Vb + (size_t)((VAR & 1) ? 0 : lk * D) * ((VAR & 8) ? 768 : NIN)); } } while (0)
    A_LOADV(0, 0); A_LOADV(1, 1);
    __builtin_amdgcn_sched_barrier(0);
    f32x16 p[5];
    float mx = -1e30f;
#pragma unroll
    for (int kb = 0; kb < 5; ++kb) {
        f32x16 acc = f32x16{};
#pragma unroll
        for (int j = 0; j < 4; ++j) *(LAS u32x4*)(ktile + kwr + j * 1024) = kst[kb % 3][j];
        if (kb + 3 < 5) A_LOADK(kb + 3, kb % 3);
        LDS_WAIT();
#pragma unroll
        for (int d0 = 0; d0 < 4; ++d0) { const bf16x8 kf = *(const LAS bf16x8*)(ktile + kfo[d0]); if (!(VAR & 2)) acc = MFMA32(kf, qr[d0], acc); else acc[d0] += __builtin_bit_cast(float, (int)kf[0]) + __builtin_bit_cast(float, (int)qr[d0][0]); }
        LDS_WAIT();
        const int lk0 = lb0 - 64 + 32 * kb;
        const int rel = 64 - 32 * kb + r32;
        int klo = rel - 64, khi = rel + 64;
        klo = klo > -lk0 ? klo : -lk0; khi = khi < L - 1 - lk0 ? khi : L - 1 - lk0;
        const unsigned span = (unsigned)(khi - klo);
        const int t0 = 4 * hi - klo;
        const bool any_ok = khi >= klo;
#pragma unroll
        for (int rr = 0; rr < 16; ++rr) { const int kk = (rr & 3) + 8 * (rr >> 2);
            const bool ok = any_ok && ((unsigned)(kk + t0) <= span);
            acc[rr] = ok ? acc[rr] : -__builtin_inff(); mx = __builtin_fmaxf(mx, acc[rr]); }
        p[kb] = acc;
    }
    const float rm = xhalf_max(mx);
    const float mnew = __builtin_fmaxf(mrun, rm);
    const float al = __builtin_amdgcn_exp2f(mrun - mnew);
    mrun = mnew;
    float ls = 0.f;
    u32x4 pw[5][2];
#pragma unroll
    for (int kb = 0; kb < 5; ++kb) {
#pragma unroll
        for (int rr = 0; rr < 16; ++rr) { p[kb][rr] = __builtin_amdgcn_exp2f(p[kb][rr] - mnew); ls += p[kb][rr]; }
        pw[kb][0] = (u32x4){cvtpk(p[kb][0], p[kb][1]), cvtpk(p[kb][2], p[kb][3]), cvtpk(p[kb][4], p[kb][5]), cvtpk(p[kb][6], p[kb][7])};
        pw[kb][1] = (u32x4){cvtpk(p[kb][8], p[kb][9]), cvtpk(p[kb][10], p[kb][11]), cvtpk(p[kb][12], p[kb][13]), cvtpk(p[kb][14], p[kb][15])};
    }
    lrun = lrun * al + ls;
    if (!FIRST) {
        if (hi == 0) wsf[r32] = al;
        LDS_WAIT();
#pragma unroll
        for (int g = 0; g < 4; ++g) { const f32x4 a4 = *(const LAS f32x4*)(wsf + 8 * g + 4 * hi);
#pragma unroll
            for (int d0 = 0; d0 < 2; ++d0)
#pragma unroll
                for (int q = 0; q < 4; ++q) o[d0][4 * g + q] *= a4[q]; }
    }
#pragma unroll
    for (int kb = 0; kb < 5; ++kb) {
#pragma unroll
        for (int q = 0; q < 4; ++q) *(LAS u32x4*)(wlds + vw + q * 512) = vst[kb & 1][q];
        if (kb + 2 < 5) A_LOADV(kb + 2, kb & 1);
        LDS_WAIT();
#pragma unroll
        for (int d0 = 0; d0 < 2; ++d0) {
            const bf16x8 vf0 = cat8(vtr(vp0 + d0 * 2048), vtr(vp0 + d0 * 2048 + 512));
            const bf16x8 vf1 = cat8(vtr(vp0 + d0 * 2048 + 1024), vtr(vp0 + d0 * 2048 + 1536));
            if (!(VAR & 2)) { o[d0] = MFMA32(__builtin_bit_cast(bf16x8, pw[kb][0]), vf0, o[d0]);
            o[d0] = MFMA32(__builtin_bit_cast(bf16x8, pw[kb][1]), vf1, o[d0]); } else { o[d0][0] += __builtin_bit_cast(float, (int)vf0[0]) + __builtin_bit_cast(float, (int)vf1[1]) + __builtin_bit_cast(float, pw[kb][0].x); }
        }
        LDS_WAIT();
    }
#undef A_LOADV
#undef A_LOADK
    const float lt = xhalf_sum(lrun);
    if (VAR & 4) { if (lt == 12345.f) mst[plq] = o[0][0] + o[1][3]; }
    else if (!LAST) {
        if (hi == 0) { mst[plq] = mrun; lst[plq] = lt; }
#pragma unroll
        for (int d0 = 0; d0 < 2; ++d0)
#pragma unroll
            for (int rr = 0; rr < 16; ++rr) *(LAS bf16_t*)(lds + A_OST + (plo + ((rr & 3) + 8 * (rr >> 2)) * D) * 128 + (32 * d0 + r32) * 2) = f2bf1(o[d0][rr]);
    } else {
        if (hi == 0) wsf[r32] = 1.f / lt;
        LDS_WAIT();
        bf16_t* Ow = mixcat + (rowbase + P0 + plo) * DM + h * 64 + r32;
#pragma unroll
        for (int g = 0; g < 4; ++g) { const f32x4 i4 = *(const LAS f32x4*)(wsf + 8 * g + 4 * hi);
#pragma unroll
            for (int q = 0; q < 4; ++q) { const int row = (q + 8 * g) * D;
#pragma unroll
                for (int d0 = 0; d0 < 2; ++d0) Ow[(size_t)row * DM + 32 * d0] = f2bf1(o[d0][4 * g + q] * i4[q]); } }
        LDS_WAIT();
    }
}
template <int VAR = 0>
__device__ __forceinline__ void dilated_phase(Frame& F, const bf16_t* proj, bf16_t* mixcat) {
    LAS unsigned char* wlds = F.lds + A_WV + F.wave * A_WVB;
    for (int c = F.vcu; c < BATCH * 4 * (SEQ / 512); c += F.G) {
        const int bh = c >> 4, b = bh >> 2, h = bh & 3, P0 = (c & 15) * 512;
        dilated_task<16, true, false, VAR>(b, h, P0, F.wave, proj, mixcat, F.lds, wlds);
        dilated_task<16, true, false, VAR>(b, h, P0, F.wave + 8, proj, mixcat, F.lds, wlds);
        __syncthreads();
        dilated_task<4, false, false, VAR>(b, h, P0, F.wave, proj, mixcat, F.lds, wlds);
        dilated_task<4, false, false, VAR>(b, h, P0, F.wave + 8, proj, mixcat, F.lds, wlds);
        __syncthreads();
        dilated_task<1, false, true, VAR>(b, h, P0, F.wave, proj, mixcat, F.lds, wlds);
        dilated_task<1, false, true, VAR>(b, h, P0, F.wave + 8, proj, mixcat, F.lds, wlds);
        __syncthreads();
    }
}

constexpr int HB_PITCH = 144;
constexpr int HB_QT = 0, HB_KT = 32 * HB_PITCH, HB_VT = 2 * 32 * HB_PITCH, HB_SC = HB_VT + 4096, HB_WAVE = 14336;
template <bool WITH_OUT>
__device__ __forceinline__ void hgrn_task(int task, int layer, const bf16_t* proj, const float* lbs, bf16_t* hs, float* hd, bf16_t* ho, LAS unsigned char* wl) {
    const int lane = opaque_tid() & 63, r32 = lane & 31, hi = lane >> 5;
    const int sc = task & 63, chain = task >> 6, dir = chain & 1, h = (chain >> 1) & 3, b = chain >> 3;
    const size_t rowbase = (size_t)b * SEQ;
    const float lb = lbs[(dir * DEPTH + layer) * 256 + h * 64 + lane];
    const float oml = 1.f - lb;
    const int zcol = (dir ? COL_FZB : COL_FZF) + h * 64 + lane;
    LAS float* scr = (LAS float*)(wl + HB_SC);
    f32x16 S[2][2];
#pragma unroll
    for (int mb = 0; mb < 2; ++mb)
#pragma unroll
        for (int vb = 0; vb < 2; ++vb) {
            if (WITH_OUT) {
                const bf16_t* sp = hs + (size_t)task * 4096 + (32 * mb + 4 * hi) * 64 + 32 * vb + r32;
#pragma unroll
                for (int rr = 0; rr < 16; ++rr) S[mb][vb][rr] = bf2f(sp[((rr & 3) + 8 * (rr >> 2)) * 64]);
            } else S[mb][vb] = f32x16{};
        }
    float atot = 0.f;
    const LAS unsigned char* vpP = wl + HB_VT + ((lane >> 4) & 1) * 32 + (lane & 3) * 8 + (4 * hi + ((lane & 15) >> 2)) * 64;
    const LAS unsigned char* vpN = wl + HB_VT + ((lane >> 4) & 1) * 32 + (lane & 3) * 8 + (8 * hi + ((lane & 15) >> 2)) * 64;
    for (int ck = 0; ck < 4; ++ck) {
        const int tau0 = sc * 128 + ck * 32;
        const long pstep = dir ? -(long)NIN : (long)NIN;
        const bf16_t* row0 = proj + (rowbase + (dir ? (SEQ - 1 - tau0) : tau0)) * NIN;
        { const int sr = lane >> 3, gc = (lane & 7) * 8;
          u32x4 zr[4], qw[4], vr[4];
#pragma unroll
          for (int j = 0; j < 4; ++j) { const bf16_t* rp = row0 + (long)(sr + 8 * j) * pstep + h * 64 + gc;
              zr[j] = *(const u32x4*)(rp + (dir ? COL_FZB : COL_FZF)); vr[j] = *(const u32x4*)(rp + COL_IB); if (WITH_OUT) qw[j] = *(const u32x4*)(rp + COL_QB); }
#pragma unroll
          for (int j = 0; j < 4; ++j) { const int s = sr + 8 * j;
              *(LAS u32x4*)(wl + HB_KT + s * 128 + (lane & 7) * 16) = zr[j];
              if (WITH_OUT) *(LAS u32x4*)(wl + HB_QT + s * 128 + (lane & 7) * 16) = qw[j];
              *(LAS u32x4*)(wl + HB_VT + ((lane & 7) >> 2) * 2048 + s * 64 + (lane & 3) * 16) = vr[j]; } }
        LDS_WAIT();
        float a[32], kk[32];
        { float run = 0.f;
#pragma unroll
          for (int s = 0; s < 32; ++s) {
              const float z = bf2f(*(const LAS bf16_t*)(wl + HB_KT + s * 128 + lane * 2));
              const float e = __expf(-z);
              const float sig = __builtin_amdgcn_rcpf(1.f + e);
              const float f = lb + oml * sig;
              run += __logf(f);
              a[s] = run;
              kk[s] = oml * (1.f - sig);
          } }
        const float alast = a[31], aref = a[15];
        atot += alast;
        scr[lane] = __expf(alast); scr[64 + lane] = __expf(aref);
        const float ela = __expf(alast - aref);
        float e2v[32];
#pragma unroll
        for (int s = 0; s < 32; ++s) { const float e1 = __expf(fminf(fmaxf(a[s] - aref, -80.f), 80.f)); e2v[s] = __builtin_amdgcn_rcpf(e1); if (WITH_OUT) a[s] = e1; }
        bf16x8 kA[2][2];
#pragma unroll
        for (int ks = 0; ks < 2; ++ks) {
            u32x4 x0, x1;
#pragma unroll
            for (int q = 0; q < 4; ++q) {
                const int s0 = 16 * ks + 2 * q, s1 = 16 * ks + 8 + 2 * q;
                x0[q] = cvtpk(kk[s0] * e2v[s0] * ela, kk[s0 + 1] * e2v[s0 + 1] * ela);
                x1[q] = cvtpk(kk[s1] * e2v[s1] * ela, kk[s1 + 1] * e2v[s1 + 1] * ela);
            }
            u32x4 f0, f1;
#pragma unroll
            for (int q = 0; q < 4; ++q) { auto rr = __builtin_amdgcn_permlane32_swap(x0[q], x1[q], false, false); f0[q] = rr[0]; f1[q] = rr[1]; }
            kA[0][ks] = __builtin_bit_cast(bf16x8, f0); kA[1][ks] = __builtin_bit_cast(bf16x8, f1);
        }
        if (WITH_OUT) {
            float qc[32];
#pragma unroll
            for (int s = 0; s < 32; ++s) qc[s] = bf2f(*(const LAS bf16_t*)(wl + HB_QT + s * 128 + lane * 2));
            LDS_WAIT();
#pragma unroll
            for (int s = 0; s < 32; ++s) {
                *(LAS bf16_t*)(wl + HB_QT + s * HB_PITCH + lane * 2) = f2bf1(qc[s] * a[s]);
                *(LAS bf16_t*)(wl + HB_KT + s * HB_PITCH + lane * 2) = f2bf1(kk[s] * e2v[s]);
            }
        }
        LDS_WAIT();
        f32x16 O[2];
        if (WITH_OUT) {
            f32x16 p = f32x16{};
#pragma unroll
            for (int kd = 0; kd < 4; ++kd) {
                const bf16x8 kf = *(const LAS bf16x8*)(wl + HB_KT + r32 * HB_PITCH + kd * 32 + hi * 16);
                const bf16x8 qf = *(const LAS bf16x8*)(wl + HB_QT + r32 * HB_PITCH + kd * 32 + hi * 16);
                p = MFMA32(kf, qf, p);
            }
#pragma unroll
            for (int rr = 0; rr < 16; ++rr) { const int s = (rr & 3) + 8 * (rr >> 2) + 4 * hi; p[rr] = (s <= r32) ? p[rr] : 0.f; }
            const u32x4 pw0 = (u32x4){cvtpk(p[0], p[1]), cvtpk(p[2], p[3]), cvtpk(p[4], p[5]), cvtpk(p[6], p[7])};
            const u32x4 pw1 = (u32x4){cvtpk(p[8], p[9]), cvtpk(p[10], p[11]), cvtpk(p[12], p[13]), cvtpk(p[14], p[15])};
#pragma unroll
            for (int vb = 0; vb < 2; ++vb) {
                const bf16x8 vf0 = cat8(vtr(vpP + vb * 2048), vtr(vpP + vb * 2048 + 512));
                const bf16x8 vf1 = cat8(vtr(vpP + vb * 2048 + 1024), vtr(vpP + vb * 2048 + 1536));
                O[vb] = MFMA32(__builtin_bit_cast(bf16x8, pw0), vf0, f32x16{});
                O[vb] = MFMA32(__builtin_bit_cast(bf16x8, pw1), vf1, O[vb]);
            }
#pragma unroll
            for (int mb = 0; mb < 2; ++mb)
#pragma unroll
                for (int sp = 0; sp < 2; ++sp) {
                    const f32x4 e0 = *(const LAS f32x4*)(scr + 64 + 32 * mb + 16 * sp + 4 * hi), e1 = *(const LAS f32x4*)(scr + 64 + 32 * mb + 16 * sp + 8 + 4 * hi);
                    const u32x2 qa = *(const LAS u32x2*)(wl + HB_QT + r32 * HB_PITCH + (32 * mb + 16 * sp + 4 * hi) * 2);
                    const u32x2 qb = *(const LAS u32x2*)(wl + HB_QT + r32 * HB_PITCH + (32 * mb + 16 * sp + 8 + 4 * hi) * 2);
                    const bf16x8 qf = __builtin_bit_cast(bf16x8, (u32x4){qa.x, qa.y, qb.x, qb.y});
#pragma unroll
                    for (int vb = 0; vb < 2; ++vb) {
                        const f32x16& X = S[mb][vb];
                        const u32x4 sw = (u32x4){cvtpk(X[8 * sp] * e0[0], X[8 * sp + 1] * e0[1]), cvtpk(X[8 * sp + 2] * e0[2], X[8 * sp + 3] * e0[3]),
                                                 cvtpk(X[8 * sp + 4] * e1[0], X[8 * sp + 5] * e1[1]), cvtpk(X[8 * sp + 6] * e1[2], X[8 * sp + 7] * e1[3])};
                        O[vb] = MFMA32(qf, __builtin_bit_cast(bf16x8, sw), O[vb]);
                    }
                }
            bf16_t* op = ho + ((size_t)dir * MTOK + rowbase) * 256 + h * 64 + r32;
#pragma unroll
            for (int vb = 0; vb < 2; ++vb)
#pragma unroll
                for (int rr = 0; rr < 16; ++rr) { const int t = (rr & 3) + 8 * (rr >> 2) + 4 * hi; const int pos = dir ? (SEQ - 1 - (tau0 + t)) : (tau0 + t);
                    op[(size_t)pos * 256 + 32 * vb] = f2bf1(O[vb][rr]); }
        }
#pragma unroll
        for (int mb = 0; mb < 2; ++mb) {
#pragma unroll
            for (int g = 0; g < 4; ++g) { const f32x4 e4 = *(const LAS f32x4*)(scr + 32 * mb + 8 * g + 4 * hi);
#pragma unroll
                for (int vb = 0; vb < 2; ++vb)
#pragma unroll
                    for (int j = 0; j < 4; ++j) S[mb][vb][4 * g + j] *= e4[j]; }
        }
#pragma unroll
        for (int vb = 0; vb < 2; ++vb)
#pragma unroll
            for (int ks = 0; ks < 2; ++ks) {
                const bf16x8 vf = cat8(vtr(vpN + vb * 2048 + ks * 1024), vtr(vpN + vb * 2048 + ks * 1024 + 256));
                S[0][vb] = MFMA32(kA[0][ks], vf, S[0][vb]);
                S[1][vb] = MFMA32(kA[1][ks], vf, S[1][vb]);
            }
        LDS_WAIT();
    }
    if (!WITH_OUT) {
        hd[(size_t)task * 64 + lane] = __expf(atot);
#pragma unroll
        for (int mb = 0; mb < 2; ++mb)
#pragma unroll
            for (int vb = 0; vb < 2; ++vb) { bf16_t* sp = hs + (size_t)task * 4096 + (32 * mb + 4 * hi) * 64 + 32 * vb + r32;
#pragma unroll
                for (int rr = 0; rr < 16; ++rr) sp[((rr & 3) + 8 * (rr >> 2)) * 64] = f2bf1(S[mb][vb][rr]); }
    }
}
template <bool WITH_OUT>
__device__ __forceinline__ void hgrn_phase(Frame& F, int layer, const bf16_t* proj) {
    const int L_tid = opaque_tid(), L_lane = L_tid & 63;
    const int gw = F.vcu * NWAVES + F.wave, NGW = F.G * NWAVES;
    LAS unsigned char* wl = F.lds + F.wave * HB_WAVE;
    for (int task = gw; task < 32 * 64; task += NGW)
        hgrn_task<WITH_OUT>(task, layer, proj, (const float*)(F.ws + WS_LBS), (bf16_t*)(F.ws + WS_HS), (float*)(F.ws + WS_HD), (bf16_t*)(F.ws + WS_HO), wl);
}
__device__ __forceinline__ void hgrn_scan(Frame& F) {
    const int L_tid = opaque_tid(), L_lane = L_tid & 63;
    const int gt = F.vcu * (NWAVES * 64) + L_tid, NT = F.G * NWAVES * 64;
    bf16_t* hs = (bf16_t*)(F.ws + WS_HS); const float* hd = (const float*)(F.ws + WS_HD);
    for (int e = gt; e < 32 * 4096; e += NT) {
        const int chain = e >> 12, dv = e & 4095, d = dv >> 6;
        float s = 0.f;
        bf16_t* p = hs + (size_t)chain * 64 * 4096 + dv; const float* dp = hd + (size_t)chain * 64 * 64 + d;
        {
            unsigned short loc[64]; float dec[64];
#pragma unroll
            for (int j = 0; j < 64; ++j) { loc[j] = p[(size_t)j * 4096]; dec[j] = dp[j * 64]; }
#pragma unroll
            for (int j = 0; j < 64; ++j) { p[(size_t)j * 4096] = f2bf1(s); s = dec[j] * s + bf2f(loc[j]); }
        }
    }
}
__device__ __forceinline__ void hgrn_combine(Frame& F, const bf16_t* proj, const float* hg, bf16_t* mixcat) {
    const int L_tid = opaque_tid(), L_lane = L_tid & 63;
    const int gw = F.vcu * NWAVES + F.wave, NGW = F.G * NWAVES;
    const bf16_t* ho = (const bf16_t*)(F.ws + WS_HO);
    const f32x4 g4 = *(const f32x4*)(hg + (L_lane & 15) * 4);
    for (int m0 = gw; m0 < MTOK; m0 += 8 * NGW) {
        u32x2 uf[8], ub[8], gz[8];
#pragma unroll
        for (int q = 0; q < 8; ++q) { const int m = (m0 + q * NGW < MTOK) ? m0 + q * NGW : m0;
            uf[q] = *(const u32x2*)(ho + (size_t)m * 256 + L_lane * 4); ub[q] = *(const u32x2*)(ho + ((size_t)MTOK + m) * 256 + L_lane * 4); gz[q] = *(const u32x2*)(proj + (size_t)m * NIN + COL_GB + L_lane * 4); }
#pragma unroll
        for (int q = 0; q < 8; ++q) { const int m = m0 + q * NGW;
            const f32x4 of = (f32x4){bf2f((unsigned short)(uf[q].x & 0xffffu)), bf2f((unsigned short)(uf[q].x >> 16)), bf2f((unsigned short)(uf[q].y & 0xffffu)), bf2f((unsigned short)(uf[q].y >> 16))};
            const f32x4 ob = (f32x4){bf2f((unsigned short)(ub[q].x & 0xffffu)), bf2f((unsigned short)(ub[q].x >> 16)), bf2f((unsigned short)(ub[q].y & 0xffffu)), bf2f((unsigned short)(ub[q].y >> 16))};
            const f32x4 v = of + ob;
            float ss = (v.x * v.x + v.y * v.y) + (v.z * v.z + v.w * v.w);
            ss += __shfl_xor(ss, 1); ss += __shfl_xor(ss, 2); ss += __shfl_xor(ss, 4); ss += __shfl_xor(ss, 8);
            const float r = __builtin_amdgcn_rsqf(ss * (1.f / 64.f) + EPS);
            const float z0 = bf2f((unsigned short)(gz[q].x & 0xffffu)), z1 = bf2f((unsigned short)(gz[q].x >> 16)), z2 = bf2f((unsigned short)(gz[q].y & 0xffffu)), z3 = bf2f((unsigned short)(gz[q].y >> 16));
            const float s0 = z0 * __builtin_amdgcn_rcpf(1.f + __expf(-z0)), s1 = z1 * __builtin_amdgcn_rcpf(1.f + __expf(-z1)), s2 = z2 * __builtin_amdgcn_rcpf(1.f + __expf(-z2)), s3 = z3 * __builtin_amdgcn_rcpf(1.f + __expf(-z3));
            u32x2 w; w.x = cvtpk(v.x * r * g4.x * s0, v.y * r * g4.y * s1); w.y = cvtpk(v.z * r * g4.z * s2, v.w * r * g4.w * s3);
            if (m < MTOK) *(u32x2*)(mixcat + (size_t)m * DM + 256 + L_lane * 4) = w; }
    }
}
__device__ __forceinline__ void hgrn_out_combine_phase(Frame& F, int layer, const bf16_t* proj, const float* hg, bf16_t* mixcat) {
    const int L_tid = opaque_tid(), L_lane = L_tid & 63;
    LAS unsigned char* wl = F.lds + F.wave * HB_WAVE;
    bf16_t* ho = (bf16_t*)(F.ws + WS_HO);
    const f32x4 g4 = *(const f32x4*)(hg + (L_lane & 15) * 4);
    for (int pg = F.vcu; pg < 256; pg += F.G) {
        const int bh = pg >> 4, scf = (pg & 15) * 4 + (F.wave >> 1);
        const int task = (F.wave & 1) ? (((2 * bh + 1) << 6) + (63 - scf)) : (((2 * bh) << 6) + scf);
        hgrn_task<true>(task, layer, proj, (const float*)(F.ws + WS_LBS), (bf16_t*)(F.ws + WS_HS), (float*)(F.ws + WS_HD), ho, wl);
        VM_WAIT();
        __syncthreads();
        const int b = bh >> 2, h = bh & 3;
        const size_t mrow = (size_t)b * SEQ + 128 * (pg & 15) * 4 + F.wave * 64 + (L_lane >> 4);
        const int col = h * 64 + (L_lane & 15) * 4;
        u32x2 uf[16], ub[16], gz[16];
#pragma unroll
        for (int q = 0; q < 16; ++q) { const size_t m = mrow + 4 * q;
            uf[q] = *(const u32x2*)(ho + m * 256 + col); ub[q] = *(const u32x2*)(ho + ((size_t)MTOK + m) * 256 + col); gz[q] = *(const u32x2*)(proj + m * NIN + COL_GB + col); }
#pragma unroll
        for (int q = 0; q < 16; ++q) { const size_t m = mrow + 4 * q;
            const f32x4 of = (f32x4){bf2f((unsigned short)(uf[q].x & 0xffffu)), bf2f((unsigned short)(uf[q].x >> 16)), bf2f((unsigned short)(uf[q].y & 0xffffu)), bf2f((unsigned short)(uf[q].y >> 16))};
            const f32x4 ob = (f32x4){bf2f((unsigned short)(ub[q].x & 0xffffu)), bf2f((unsigned short)(ub[q].x >> 16)), bf2f((unsigned short)(ub[q].y & 0xffffu)), bf2f((unsigned short)(ub[q].y >> 16))};
            const f32x4 v = of + ob;
            float ss = (v.x * v.x + v.y * v.y) + (v.z * v.z + v.w * v.w);
            ss += __shfl_xor(ss, 1); ss += __shfl_xor(ss, 2); ss += __shfl_xor(ss, 4); ss += __shfl_xor(ss, 8);
            const float r = __builtin_amdgcn_rsqf(ss * (1.f / 64.f) + EPS);
            const float z0 = bf2f((unsigned short)(gz[q].x & 0xffffu)), z1 = bf2f((unsigned short)(gz[q].x >> 16)), z2 = bf2f((unsigned short)(gz[q].y & 0xffffu)), z3 = bf2f((unsigned short)(gz[q].y >> 16));
            const float s0 = z0 * __builtin_amdgcn_rcpf(1.f + __expf(-z0)), s1 = z1 * __builtin_amdgcn_rcpf(1.f + __expf(-z1)), s2 = z2 * __builtin_amdgcn_rcpf(1.f + __expf(-z2)), s3 = z3 * __builtin_amdgcn_rcpf(1.f + __expf(-z3));
            u32x2 w; w.x = cvtpk(v.x * r * g4.x * s0, v.y * r * g4.y * s1); w.y = cvtpk(v.z * r * g4.z * s2, v.w * r * g4.w * s3);
            *(u32x2*)(mixcat + m * DM + 256 + col) = w; }
        __syncthreads();
    }
}

struct Args { const float* in[15]; float* out; unsigned char* ws; };
typedef __attribute__((address_space(4))) const Args CArgs;
__device__ __forceinline__ CArgs* kargs() { auto p = __builtin_amdgcn_kernarg_segment_ptr(); asm volatile("" : "+s"(p)); return (CArgs*)p; }
#define AIN(i) (kargs()->in[(i)])
__global__ void __launch_bounds__(NWAVES * 64, 2) fwd_kernel(Args args) {
    extern __shared__ __attribute__((aligned(16))) unsigned char lds[];
    Frame F;
    F.lds = (LAS unsigned char*)lds;
    F.wave = __builtin_amdgcn_readfirstlane((int)threadIdx.x >> 6);
    F.G = gridDim.x; { const int bx = blockIdx.x; F.vcu = (F.G % 8 == 0) ? (bx % 8) * (F.G / 8) + bx / 8 : bx; }
    F.ws = args.ws;
    volatile LAS unsigned* MISC = (volatile LAS unsigned*)(F.lds + MISC_OFF);
    for (int u = threadIdx.x; u < (LDS_BYTES - LDSCTL_OFF) / 4; u += NWAVES * 64) ((LAS unsigned*)(F.lds + LDSCTL_OFF))[u] = 0u;
    __syncthreads();
    XcdBarrier bar = xcd_barrier_post((unsigned*)(args.ws + WS_CTL) + CW_BAR, MISC + 8);
#define GRID_BAR() xcd_barrier(bar)

    unsigned char* ws = args.ws;
    bf16_t* XN = (bf16_t*)(ws + WS_XN);
    bf16_t* X16 = (bf16_t*)(ws + WS_X16);
    float* RSA = (float*)(ws + WS_BR + 16 * MiB);
    float* RSB = RSA + 4 * MTOK;
    unsigned* XBUF = (unsigned*)(ws + WS_HD);
    unsigned* PCNT = (unsigned*)(ws + WS_CTL) + 8192;
    bf16_t* PROJ = (bf16_t*)(ws + WS_BIG);
    bf16_t* ACT = (bf16_t*)(ws + WS_ACT);
    bf16_t* BR = (bf16_t*)(ws + WS_BR);

    prologue_small(F, AIN(3), AIN(5));
    convert_weights(F, AIN(1), AIN(2), AIN(7), AIN(10), AIN(11), AIN(13));
    init_rows(F, AIN(0), X16, RSB);
    GRID_BAR();

    for (int l = 0; l < DEPTH; ++l) {
        { pg8::Gemm g{X16, (const bf16_t*)(ws + WS_WIN), MTOK, NIN, DM}; pg8::StaticOrder S; S.init(MTOK, NIN, F.G, (int)blockIdx.x);
          pg8::EpiProj E{PROJ, (const float*)(ws + WS_ROPE), RSB};
          pg8::gemm_phase<pg8::EpiProj, pg8::StaticOrder, true, true>(F.lds, g, S, E); }
        GRID_BAR();
        dilated_phase(F, PROJ, XN);
        __syncthreads();
        hgrn_phase<false>(F, l, PROJ);
        GRID_BAR();
        hgrn_scan(F);
        GRID_BAR();
        hgrn_out_combine_phase(F, l, PROJ, AIN(4) + l * 64, XN);
        { const float lam_init = (l == 0) ? 0.2f : (l == 1) ? 0.35550906759096934f : (l == 2) ? 0.4707130183435842f : 0.5560582041556406f;
          diffattn_phase<0>(F, PROJ, XN, (const float*)(ws + WS_LAM) + l, 1.f - lam_init, AIN(6) + l * 128); }
        GRID_BAR();
        for (int sl = 0; sl < 2; ++sl) {
            pg8::Gemm g{XN, (const bf16_t*)(ws + WS_WOUT), MTOK, DM, DM}; pg8::SliceOrder S; S.init(MTOK, DM, F.G, (int)blockIdx.x, sl);
            pg8::EpiRmsRes E{X16, nullptr, AIN(12) + l * DM, RSA, XBUF, PCNT, 32u * (unsigned)(2 * l + 1)};
            pg8::gemm_phase<pg8::EpiRmsRes, pg8::SliceOrder, true, true>(F.lds, g, S, E);
            __syncthreads();
        }
        GRID_BAR();
        { pg8::Gemm g{X16, (const bf16_t*)(ws + WS_WUP), MTOK, NUP, DM}; pg8::StaticOrder S; S.init(MTOK, NUP, F.G, (int)blockIdx.x);
          pg8::EpiConv E{ACT, (bf16_t*)(ws + WS_HALO), AIN(8) + (size_t)l * 3 * NUP, AIN(9) + (size_t)l * NUP, RSA};
          pg8::gemm_phase<pg8::EpiConv, pg8::StaticOrder, true, true>(F.lds, g, S, E); }
        GRID_BAR();
        conv_fixup(F, (const bf16_t*)(ws + WS_HALO), ACT, AIN(8) + (size_t)l * 3 * NUP, AIN(9) + (size_t)l * NUP);
        GRID_BAR();
        for (int sl = 0; sl < 2; ++sl) {
            pg8::Gemm g{ACT, (const bf16_t*)(ws + WS_WDN), MTOK, DM, DFF}; pg8::SliceOrder S; S.init(MTOK, DM, F.G, (int)blockIdx.x, sl);
            pg8::EpiRmsRes E{X16, (l + 1 < DEPTH) ? nullptr : kargs()->out, AIN(14) + l * DM, (l + 1 < DEPTH) ? RSB : nullptr, XBUF, PCNT, 32u * (unsigned)(2 * l + 2)};
            pg8::gemm_phase<pg8::EpiRmsRes, pg8::SliceOrder, true, true>(F.lds, g, S, E);
            __syncthreads();
        }
        if (l + 1 < DEPTH) {
            __syncthreads();
            convert_weights(F, AIN(1) + (size_t)(l + 1) * DM * NIN, AIN(2) + (size_t)(l + 1) * DM * DM, AIN(7) + (size_t)(l + 1) * DM * NUP, AIN(10) + (size_t)(l + 1) * DFF * DM, AIN(11) + (l + 1) * DM, AIN(13) + (l + 1) * DM);
            GRID_BAR();
        }
    }
}

extern "C" void kernel_launch(void* const* d_in, const int* in_sizes, int n_in, void* d_out, int out_size, void* d_ws, size_t ws_size, hipStream_t stream) {
    static int grid = 0;
    if (grid == 0) {
        if (n_in != 15 || in_sizes[0] != MTOK * DM || out_size != MTOK * DM || ws_size < WS_END) {
            fprintf(stderr, "kernel_launch: unexpected shapes (n_in %d, in0 %d, out %d, ws %zu); nothing launched\n", n_in, n_in > 0 ? in_sizes[0] : -1, out_size, ws_size); grid = -1; return; }
        int dev = 0, cus = 0;
        if (hipGetDevice(&dev) != hipSuccess || hipDeviceGetAttribute(&cus, hipDeviceAttributeMultiprocessorCount, dev) != hipSuccess) { grid = -1; return; }
        if (hipFuncSetAttribute((const void*)fwd_kernel, hipFuncAttributeMaxDynamicSharedMemorySize, LDS_BYTES) != hipSuccess) { grid = -1; return; }
        int per_cu = 0;
        if (hipOccupancyMaxActiveBlocksPerMultiprocessor(&per_cu, (const void*)fwd_kernel, NWAVES * 64, LDS_BYTES) != hipSuccess || per_cu < 1)
            fprintf(stderr, "kernel_launch: occupancy query reports %d workgroups per CU\n", per_cu);
        (void)hipGetLastError();
        grid = cus;
    }
    if (grid < 0) return;
    if (hipMemsetAsync((char*)d_ws + WS_CTL, 0, CTL_ZERO_BYTES, stream) != hipSuccess) return;
    Args a{};
    for (int i = 0; i < 15; ++i) a.in[i] = (const float*)d_in[i];
    a.out = (float*)d_out; a.ws = (unsigned char*)d_ws;
    hipLaunchKernelGGL(fwd_kernel, dim3(grid), dim3(NWAVES * 64), LDS_BYTES, stream, a);
}
```
